# Optimizing an MI355X kernel written in HIP

```python
import jax
import jax.numpy as jnp
from jax import lax
import numpy as np

D_MODEL = 2048
BATCH = 2
SEQ = 4096
DEPTH = 1

GRID_W = 64
CTX_LEN = 256
D_CONV = D_MODEL // 2
D_REC = D_MODEL // 2
REC_DK = 128
REC_HEADS = D_REC // REC_DK
REC_DV = D_REC // REC_HEADS
REC_CHUNK = 64
CONV_K = 31
D_FF = 4 * D_MODEL
D_IN = 2 * D_CONV + 5 * D_REC
NORM_EPS = 1e-6

kernel_name = "hybrid_conformer_hgrn2_prefix_dit_block"


def rms_norm(x, w):
    xf = x.astype(jnp.float32)
    y = xf * lax.rsqrt(jnp.mean(xf * xf, axis=-1, keepdims=True) + NORM_EPS)
    return (y * w.astype(jnp.float32)).astype(x.dtype)


def layer_norm(x, w, b):
    xf = x.astype(jnp.float32)
    mu = jnp.mean(xf, axis=-1, keepdims=True)
    var = jnp.mean(jnp.square(xf - mu), axis=-1, keepdims=True)
    y = (xf - mu) * lax.rsqrt(var + NORM_EPS)
    return (y * w.astype(jnp.float32) + b.astype(jnp.float32)).astype(x.dtype)


def modulate(h, shift, scale):
    return h * (1 + scale) + shift


def heads(t):
    return t.reshape(t.shape[:-1] + (REC_HEADS, -1))


def flip(t):
    return jnp.flip(t, axis=1)


def depthwise_conv(u, w, b):
    pad = CONV_K // 2
    y = lax.conv_general_dilated(
        u, w[:, None, :].astype(u.dtype), window_strides=(1,), padding=[(pad, pad)],
        dimension_numbers=("NWC", "WIO", "NWC"), feature_group_count=u.shape[-1])
    return y + b.astype(u.dtype)


def conformer_branch(zc, conv_w, conv_b, ln_w, ln_b):
    a, gt = jnp.split(zc, 2, axis=-1)
    u = a * jax.nn.sigmoid(gt)
    u = depthwise_conv(u, conv_w, conv_b)
    return jax.nn.silu(layer_norm(u, ln_w, ln_b))


def rec_gate(fx, lb):
    f = lb + (1 - lb) * jax.nn.sigmoid(fx.astype(jnp.float32))
    return heads(1 - f), heads(jnp.log(f))


def gla_chunked(q, k, v, logf, s0):
    bsz, seq, nh, _ = k.shape
    n = seq // REC_CHUNK

    def blocks(t):
        return t.astype(jnp.float32).reshape(bsz, n, REC_CHUNK, nh, t.shape[-1]).transpose(1, 0, 3, 2, 4)

    kc, vc, gc = blocks(k), blocks(v), blocks(logf)
    b = jnp.cumsum(gc, axis=3)
    b_last = b[:, :, :, -1:, :]
    kv = jnp.einsum("nbhcd,nbhce->nbhde", kc * jnp.exp(b_last - b), vc)
    decay = jnp.exp(b_last[:, :, :, 0, :])

    def step(s, inp):
        dcy, kv_n = inp
        return dcy[..., None] * s + kv_n, s

    s_final, s_in = lax.scan(step, s0.astype(jnp.float32), (decay, kv))
    if q is None:
        return None, s_final
    qc = blocks(q)
    ref = REC_CHUNK // 2 - 1
    b_ref = b[:, :, :, ref:ref + 1, :]
    scores = jnp.einsum("nbhtd,nbhsd->nbhts", qc * jnp.exp(b - b_ref), kc * jnp.exp(b_ref - b))
    mask = jnp.tril(jnp.ones((REC_CHUNK, REC_CHUNK), dtype=bool))
    scores = jnp.where(mask, scores, 0.0)
    o = (jnp.einsum("nbhts,nbhse->nbhte", scores, vc)
         + jnp.einsum("nbhtd,nbhde->nbhte", qc * jnp.exp(b), s_in))
    o = o.transpose(1, 0, 3, 2, 4).reshape(bsz, seq, nh, v.shape[-1])
    return o, s_final


def bidir_hgrn2(q, i, ff, fb, lb, s0_f, s0_b):
    k_f, g_f = rec_gate(ff, lb[0])
    k_b, g_b = rec_gate(fb, lb[1])
    v = heads(i)
    qh = None if q is None else heads(jax.nn.silu(q))
    o_f, s_f = gla_chunked(qh, k_f, v, g_f, s0_f)
    o_b, s_b = gla_chunked(None if qh is None else flip(qh), flip(k_b), flip(v), flip(g_b), s0_b)
    if q is None:
        return None, s_f, s_b
    return o_f + flip(o_b), s_f, s_b


def mixer(h, w_in, w_out, conv_w, conv_b, ln_w, ln_b, lb, rec_norm_w, s0_f, s0_b):
    z = h @ w_in
    zc = z[..., :2 * D_CONV]
    q, g, i, ff, fb = jnp.split(z[..., 2 * D_CONV:], 5, axis=-1)
    u = conformer_branch(zc, conv_w, conv_b, ln_w, ln_b)
    o, s_f, s_b = bidir_hgrn2(q, i, ff, fb, lb, s0_f, s0_b)
    o = rms_norm(o, rec_norm_w.reshape(REC_HEADS, REC_DV)).astype(h.dtype)
    o = o.reshape(h.shape[:-1] + (D_REC,)) * jax.nn.silu(g)
    y = jnp.concatenate([u, o], axis=-1) @ w_out
    return y, s_f, s_b


def context_rec_states(h_ctx, w_in, lb, s0):
    z = h_ctx @ w_in[:, 2 * D_CONV + 2 * D_REC:]
    i, ff, fb = jnp.split(z, 3, axis=-1)
    _, s_f, s_b = bidir_hgrn2(None, i, ff, fb, lb, s0, s0)
    return s_f, s_b


def sq_relu_mlp(h, w_up, w_down):
    return jnp.square(jax.nn.relu(h @ w_up)) @ w_down


def setup_inputs(seed: int = 0) -> dict:
    key = jax.random.key(seed)
    ks = jax.random.split(key, 20)
    D = D_MODEL

    def nrm(k, shape, s):
        return jax.random.normal(k, shape, jnp.float32) * s

    return {
        "x": nrm(ks[0], (BATCH, SEQ, D), 1.0),
        "c": nrm(ks[1], (BATCH, D), 1.0),
        "ctx": nrm(ks[2], (BATCH, CTX_LEN, D), 1.0),
        "c_ctx": nrm(ks[3], (D,), 1.0),
        "w_ada": nrm(ks[4], (DEPTH, D, 6 * D), D ** -0.5),
        "b_ada": nrm(ks[5], (DEPTH, 6 * D), 0.02),
        "mix_pre_w": 1.0 + nrm(ks[6], (DEPTH, D), 0.02),
        "mix_post_w": 1.0 + nrm(ks[7], (DEPTH, D), 0.02),
        "mlp_pre_w": 1.0 + nrm(ks[8], (DEPTH, D), 0.02),
        "mlp_post_w": 1.0 + nrm(ks[9], (DEPTH, D), 0.02),
        "w_in": nrm(ks[10], (DEPTH, D, D_IN), D ** -0.5),
        "conv_w": nrm(ks[11], (DEPTH, CONV_K, D_CONV), CONV_K ** -0.5),
        "conv_b": nrm(ks[12], (DEPTH, D_CONV), 0.02),
        "conv_ln_w": 1.0 + nrm(ks[13], (DEPTH, D_CONV), 0.02),
        "conv_ln_b": nrm(ks[14], (DEPTH, D_CONV), 0.02),
        "rec_lb_logits": nrm(ks[15], (DEPTH + 1, 2, D_REC), 0.1),
        "rec_norm_w": 1.0 + nrm(ks[16], (DEPTH, D_REC), 0.02),
        "w_out": nrm(ks[17], (DEPTH, D_CONV + D_REC, D), (D_CONV + D_REC) ** -0.5),
        "w_up": nrm(ks[18], (DEPTH, D, D_FF), D ** -0.5),
        "w_down": nrm(ks[19], (DEPTH, D_FF, D), D_FF ** -0.5),
    }


def reference(x, c, ctx, c_ctx, w_ada, b_ada, mix_pre_w, mix_post_w, mlp_pre_w, mlp_post_w,
              w_in, conv_w, conv_b, conv_ln_w, conv_ln_b, rec_lb_logits, rec_norm_w,
              w_out, w_up, w_down):
    bsz = x.shape[0]
    lb_all = jnp.cumsum(jax.nn.softmax(rec_lb_logits.astype(jnp.float32), axis=0), axis=0)
    s_zero = jnp.zeros((bsz, REC_HEADS, REC_DK, REC_DV), jnp.float32)
    for l in range(DEPTH):
        mod_x = (jax.nn.silu(c) @ w_ada[l] + b_ada[l])[:, None, :]
        mod_c = jax.nn.silu(c_ctx) @ w_ada[l] + b_ada[l]
        sh1x, sc1x, g1x, sh2x, sc2x, g2x = jnp.split(mod_x, 6, axis=-1)
        sh1c, sc1c, g1c, sh2c, sc2c, g2c = jnp.split(mod_c, 6, axis=-1)
        lb = lb_all[l]

        hc = modulate(rms_norm(ctx, mix_pre_w[l]), sh1c, sc1c)
        if l < DEPTH - 1:
            yc, s_f, s_b = mixer(hc, w_in[l], w_out[l], conv_w[l], conv_b[l], conv_ln_w[l], conv_ln_b[l],
                                 lb, rec_norm_w[l], s_zero, s_zero)
            ctx = ctx + g1c * rms_norm(yc, mix_post_w[l])
            hc2 = modulate(rms_norm(ctx, mlp_pre_w[l]), sh2c, sc2c)
            ctx = ctx + g2c * rms_norm(sq_relu_mlp(hc2, w_up[l], w_down[l]), mlp_post_w[l])
        else:
            s_f, s_b = context_rec_states(hc, w_in[l], lb, s_zero)

        hx = modulate(rms_norm(x, mix_pre_w[l]), sh1x, sc1x)
        yx, _, _ = mixer(hx, w_in[l], w_out[l], conv_w[l], conv_b[l], conv_ln_w[l], conv_ln_b[l],
                         lb, rec_norm_w[l], s_f, s_b)
        x = x + g1x * rms_norm(yx, mix_post_w[l])
        hx2 = modulate(rms_norm(x, mlp_pre_w[l]), sh2x, sc2x)
        x = x + g2x * rms_norm(sq_relu_mlp(hx2, w_up[l], w_down[l]), mlp_post_w[l])
    return x
```

```cpp
#include <hip/hip_runtime.h>
#include <hip/hip_cooperative_groups.h>
#include <cstdio>
#include <cstdint>
namespace cg = cooperative_groups;
namespace pg8 {
#define PG8_LAS __attribute__((address_space(3)))
typedef unsigned short bf16_t;
typedef short bf16x8 __attribute__((ext_vector_type(8)));
typedef float f32x4 __attribute__((ext_vector_type(4)));
typedef unsigned u32x4 __attribute__((ext_vector_type(4)));
constexpr int BM = 256, BK = 64, HALF = 128, HTB = HALF * BK * 2  , STAGE_BYTES = 8 * HTB, NXCD = 8, WGM = 8;

__host__ __device__ __forceinline__ int lds_byte(int r, int c) { const int st = (r >> 4) * 2 + (c >> 5), rr = r & 15, cc = c & 31, ob = rr * 64 + cc * 2; return st * 1024 + (ob ^ (((ob >> 9) & 1) << 5)); }
__host__ __device__ __forceinline__ void stage_rc(int b, int& R, int& C) { const int st = b / 1024, sb = b % 1024, swz = sb ^ (((sb >> 9) & 1) << 5); R = (st >> 1) * 16 + swz / 64; C = (st & 1) * 32 + (swz % 64) / 2; }
__host__ __device__ __forceinline__ int perm32(int rho) { const int n = rho >> 4, i = rho & 15; return 8 * (i >> 2) + 4 * n + (i & 3); }

struct Unit { int pm, pn; };
struct Gemm { const bf16_t* A; const bf16_t* Bt; int M, N, K; };

struct StaticOrder {
    int nM, nN, nwg, G, c;
    __host__ __device__ void init(int M, int N, int G_, int c_) { nM = M / BM; nN = N / BM; nwg = nM * nN; G = G_; c = c_; }
    __host__ __device__ bool next(int i, Unit& u) const {
        const long L = (long)i * G + c; if (L >= nwg) return false;
        int wgid = (int)L; { const int q = nwg / NXCD, r = nwg % NXCD, xcd = wgid % NXCD, off = wgid / NXCD; wgid = (xcd < r ? xcd * (q + 1) : r * (q + 1) + (xcd - r) * q) + off; }
        const int nig = WGM * nN, gid = wgid / nig, fm = gid * WGM, gsz = (nM - fm) < WGM ? (nM - fm) : WGM;
        u.pm = fm + ((wgid % nig) % gsz); u.pn = (wgid % nig) / gsz; return true;
    }
    __device__ __forceinline__ void a_ready(const Unit&) const {}
    __device__ __forceinline__ void done(const Unit&) const {}
};

__device__ __forceinline__ unsigned cvt_pk_bf16(float lo, float hi) { unsigned r; asm volatile("v_cvt_pk_bf16_f32 %0, %1, %2" : "=v"(r) : "v"(lo), "v"(hi)); return r; }
typedef float f32x2 __attribute__((ext_vector_type(2)));
template <int ACT  > struct EpiBf {
    static constexpr bool PERM = true, AFTER_DRAIN = false;
    bf16_t* O; int ldc;
    __device__ __forceinline__ void operator()(const f32x4 (&acc)[2][2][4][2], const Unit& u, int wr, int wc, int fr, int fq) const {
        const int row0 = u.pm * BM + wr * 64 + fr, col0 = u.pn * BM + wc * 32 + 8 * fq;
#pragma unroll
        for (int ai = 0; ai < 2; ++ai)
#pragma unroll
            for (int m = 0; m < 4; ++m) { bf16_t* rowp = O + (size_t)(row0 + ai * HALF + m * 16) * ldc + col0;
#pragma unroll
                for (int bj = 0; bj < 2; ++bj) { f32x4 v0 = acc[ai][bj][m][0], v1 = acc[ai][bj][m][1];
                    if (ACT == 2) {
#pragma unroll
                        for (int e = 0; e < 4; ++e) { float a = fmaxf(v0[e], 0.f), b = fmaxf(v1[e], 0.f); v0[e] = a * a; v1[e] = b * b; } }
                    u32x4 w; w.x = cvt_pk_bf16(v0[0], v0[1]); w.y = cvt_pk_bf16(v0[2], v0[3]); w.z = cvt_pk_bf16(v1[0], v1[1]); w.w = cvt_pk_bf16(v1[2], v1[3]);
                    *(u32x4*)(rowp + bj * HALF) = w; } }
    }
};
struct EpiF32 {
    static constexpr bool PERM = false, AFTER_DRAIN = false;
    float* O; int ldc;
    __device__ __forceinline__ void operator()(const f32x4 (&acc)[2][2][4][2], const Unit& u, int wr, int wc, int fr, int fq) const {
        const int col0 = u.pn * BM + wc * 32 + 4 * fq;
#pragma unroll
        for (int ai = 0; ai < 2; ++ai)
#pragma unroll
            for (int m = 0; m < 4; ++m) { float* rowp = O + (size_t)(u.pm * BM + ai * HALF + wr * 64 + m * 16 + fr) * ldc + col0;
#pragma unroll
                for (int bj = 0; bj < 2; ++bj)
#pragma unroll
                    for (int n = 0; n < 2; ++n) *(f32x4*)(rowp + bj * HALF + n * 16) = acc[ai][bj][m][n]; }
    }
};
struct Sched1 {
    StaticOrder so; int G, c;
    __device__ void init(int G_, int c_) { so.init(8192, 7168, G_, c_); G = G_; c = c_; }
    __device__ bool next(int i, Unit& u) const {
        if (so.next(i, u)) return true;
        const long L = (long)i * G + c - so.nwg; if (L < 0 || L >= 24) return false;
        u.pm = 32 + (int)(L & 1); u.pn = 16 + (int)(L >> 1); return true;
    }
    __device__ __forceinline__ void a_ready(const Unit&) const {}
    __device__ __forceinline__ void done(const Unit&) const {}
};
template <class Epi, class Sched, bool ALIGN_EPI = false, bool SP2 = false>
__device__ __forceinline__ void gemm_phase(PG8_LAS unsigned char* lds, const Gemm g, const Sched& S, const Epi& E) {
    int tid_ = threadIdx.x; asm volatile("" : "+v"(tid_));
    const int tid = tid_, wid = __builtin_amdgcn_readfirstlane(tid >> 6), lane = tid & 63, wr = wid >> 2, wc = wid & 3, fr = lane & 15, fq = lane >> 4;
    const int K = g.K, nt = K / BK;
    unsigned voffA[2], voffB[2];
#pragma unroll
    for (int i = 0; i < 2; ++i) { int R, C; stage_rc(tid * 16 + i * 8192, R, C); const int Rb = Epi::PERM ? ((R & ~31) + perm32(R & 31)) : R;
        voffA[i] = (unsigned)(R * K + C) * 2u; voffB[i] = (unsigned)(Rb * K + C) * 2u; }
    const size_t kstep = (size_t)(BK * 2);
    const size_t hstep = (size_t)HALF * K * 2;
    const size_t tstep = 2 * hstep;
    const unsigned ldsw = (unsigned)wid * 1024u;
    const int aoff = lds_byte(wr * 64 + fr, fq * 8), boff = lds_byte(wc * 32 + fr, fq * 8);
#define PG8_SA(b, h) (((b) * 2 + (h)) * HTB)
#define PG8_SB(b, h) ((4 + (b) * 2 + (h)) * HTB)
#define PG8_STAGE(bufoff, gbase, voff) do { _Pragma("unroll") for (int _i = 0; _i < 2; ++_i) \
        __builtin_amdgcn_global_load_lds((const unsigned*)((const char*)(gbase) + (voff)[_i]), (PG8_LAS unsigned*)(lds + (bufoff) + ldsw + _i * 8192), 16, 0, 0); } while (0)
#define PG8_LDA(dst, b, h) do { _Pragma("unroll") for (int m = 0; m < 4; ++m) _Pragma("unroll") for (int k = 0; k < 2; ++k) dst[m][k] = *(const PG8_LAS bf16x8*)(lds + PG8_SA(b, h) + aoff + m * 2048 + k * 1024); } while (0)
#define PG8_LDB(dst, b, h) do { _Pragma("unroll") for (int n = 0; n < 2; ++n) _Pragma("unroll") for (int k = 0; k < 2; ++k) dst[n][k] = *(const PG8_LAS bf16x8*)(lds + PG8_SB(b, h) + boff + n * 2048 + k * 1024); } while (0)
#define PG8_MMA(ai, bj, At, Bt) do { __builtin_amdgcn_s_setprio(1); _Pragma("unroll") for (int m = 0; m < 4; ++m) _Pragma("unroll") for (int n = 0; n < 2; ++n) _Pragma("unroll") for (int k = 0; k < 2; ++k) \
        acc[ai][bj][m][n] = __builtin_amdgcn_mfma_f32_16x16x32_bf16(Bt[n][k], At[m][k], acc[ai][bj][m][n], 0, 0, 0); __builtin_amdgcn_s_setprio(0); } while (0)
#define PG8_WAIT_V(n) asm volatile("s_waitcnt vmcnt(" #n ")" ::: "memory")
#define PG8_WAIT_L(n) asm volatile("s_waitcnt lgkmcnt(" #n ")" ::: "memory")
#define PG8_BAR __builtin_amdgcn_s_barrier()
#define PG8_SCHED __builtin_amdgcn_sched_barrier(0)
    Unit cur, nxt; int ui = 0;
    if (!S.next(0, cur)) return;
    f32x4 acc[2][2][4][2];
#pragma unroll
    for (int a = 0; a < 2; ++a)
#pragma unroll
        for (int b = 0; b < 2; ++b)
#pragma unroll
            for (int m = 0; m < 4; ++m)
#pragma unroll
                for (int n = 0; n < 2; ++n) acc[a][b][m][n] = (f32x4){0.f, 0.f, 0.f, 0.f};
    bf16x8 At[4][2], B0[2][2], B1[2][2];
    const char* cA = (const char*)g.A + (size_t)cur.pm * tstep; const char* cB = (const char*)g.Bt + (size_t)cur.pn * tstep;
    S.a_ready(cur);
    if constexpr (SP2) {
        PG8_STAGE(PG8_SB(0, 0), cB, voffB); PG8_STAGE(PG8_SB(0, 1), cB + hstep, voffB); PG8_STAGE(PG8_SA(0, 0), cA, voffA); PG8_STAGE(PG8_SA(0, 1), cA + hstep, voffA);
        if (wr == 1) PG8_BAR;
        PG8_WAIT_V(2); PG8_BAR;
        PG8_STAGE(PG8_SB(1, 0), cB + kstep, voffB); PG8_STAGE(PG8_SA(1, 0), cA + kstep, voffA); PG8_STAGE(PG8_SB(1, 1), cB + hstep + kstep, voffB);
        PG8_WAIT_V(6); PG8_BAR;
    } else {
        PG8_STAGE(PG8_SB(0, 0), cB, voffB); PG8_STAGE(PG8_SA(0, 0), cA, voffA); PG8_STAGE(PG8_SB(0, 1), cB + hstep, voffB); PG8_STAGE(PG8_SA(0, 1), cA + hstep, voffA);
        if (wr == 1) PG8_BAR;
        PG8_WAIT_V(4); PG8_BAR;
        PG8_STAGE(PG8_SB(1, 0), cB + kstep, voffB); PG8_STAGE(PG8_SA(1, 0), cA + kstep, voffA); PG8_STAGE(PG8_SB(1, 1), cB + hstep + kstep, voffB);
        PG8_WAIT_V(6); PG8_BAR;
    }
    for (;;) {
        const bool has_next = S.next(ui + 1, nxt);
        const char* nA = has_next ? (const char*)g.A + (size_t)nxt.pm * tstep : cA; const char* nB = has_next ? (const char*)g.Bt + (size_t)nxt.pn * tstep : cB;
        for (int t = 0; t < nt; t += 2) {
            const bool last = (t == nt - 2);
            const char* a1 = cA + (size_t)(t + 1) * kstep;
            const char* a2 = last ? nA : cA + (size_t)(t + 2) * kstep; const char* b2 = last ? nB : cB + (size_t)(t + 2) * kstep;
            const char* a3 = a2 + kstep; const char* b3 = b2 + kstep;
            if (last && has_next) S.a_ready(nxt);
            if constexpr (SP2) {
            PG8_LDB(B0, 0, 0); PG8_LDB(B1, 0, 1); PG8_SCHED; PG8_LDA(At, 0, 0); PG8_STAGE(PG8_SA(1, 1), a1 + hstep, voffA);
            PG8_WAIT_V(8); PG8_WAIT_L(0); PG8_BAR; PG8_MMA(0, 0, At, B0); PG8_MMA(0, 1, At, B1); PG8_BAR; PG8_SCHED;
            PG8_LDA(At, 0, 1); PG8_STAGE(PG8_SB(0, 0), b2, voffB); PG8_STAGE(PG8_SB(0, 1), b2 + hstep, voffB); PG8_STAGE(PG8_SA(0, 0), a2, voffA);
            PG8_WAIT_V(8); PG8_WAIT_L(0); PG8_BAR; PG8_MMA(1, 0, At, B0); PG8_MMA(1, 1, At, B1); PG8_BAR; PG8_SCHED;
            PG8_LDB(B0, 1, 0); PG8_LDB(B1, 1, 1); PG8_SCHED; PG8_LDA(At, 1, 0); PG8_STAGE(PG8_SA(0, 1), a2 + hstep, voffA);
            PG8_WAIT_V(8); PG8_WAIT_L(0); PG8_BAR; PG8_MMA(0, 0, At, B0); PG8_MMA(0, 1, At, B1); PG8_BAR; PG8_SCHED;
            PG8_LDA(At, 1, 1); PG8_STAGE(PG8_SB(1, 0), b3, voffB); PG8_STAGE(PG8_SB(1, 1), b3 + hstep, voffB); PG8_STAGE(PG8_SA(1, 0), a3, voffA);
            PG8_WAIT_V(8); PG8_WAIT_L(0); PG8_BAR; PG8_MMA(1, 0, At, B0); PG8_MMA(1, 1, At, B1); PG8_BAR; PG8_SCHED;
            } else {
            PG8_LDB(B0, 0, 0); PG8_SCHED; PG8_LDA(At, 0, 0); PG8_STAGE(PG8_SA(1, 1), a1 + hstep, voffA);
            PG8_WAIT_L(8); PG8_BAR; PG8_WAIT_L(0); PG8_MMA(0, 0, At, B0); PG8_BAR; PG8_SCHED;
            PG8_LDB(B1, 0, 1); PG8_STAGE(PG8_SB(0, 0), b2, voffB);
            PG8_BAR; PG8_WAIT_L(0); PG8_MMA(0, 1, At, B1); PG8_BAR;
            PG8_LDA(At, 0, 1); PG8_STAGE(PG8_SA(0, 0), a2, voffA);
            PG8_BAR; PG8_WAIT_L(0); PG8_MMA(1, 0, At, B0); PG8_BAR; PG8_SCHED;
            PG8_STAGE(PG8_SB(0, 1), b2 + hstep, voffB);
            PG8_WAIT_V(6); PG8_BAR; PG8_MMA(1, 1, At, B1); PG8_BAR;
            PG8_LDB(B0, 1, 0); PG8_SCHED; PG8_LDA(At, 1, 0); PG8_STAGE(PG8_SA(0, 1), a2 + hstep, voffA);
            PG8_WAIT_L(8); PG8_BAR; PG8_WAIT_L(0); PG8_MMA(0, 0, At, B0); PG8_BAR; PG8_SCHED;
            PG8_LDB(B1, 1, 1); PG8_STAGE(PG8_SB(1, 0), b3, voffB);
            PG8_BAR; PG8_WAIT_L(0); PG8_MMA(0, 1, At, B1); PG8_BAR;
            PG8_LDA(At, 1, 1); PG8_STAGE(PG8_SA(1, 0), a3, voffA);
            PG8_BAR; PG8_WAIT_L(0); PG8_MMA(1, 0, At, B0); PG8_BAR; PG8_SCHED;
            PG8_STAGE(PG8_SB(1, 1), b3 + hstep, voffB);
            PG8_WAIT_V(6); PG8_BAR; PG8_MMA(1, 1, At, B1); PG8_BAR;
            }
        }
        if constexpr (ALIGN_EPI) { if (wr == 0) PG8_BAR; }
        if constexpr (!Epi::AFTER_DRAIN) { E(acc, cur, wr, wc, fr, fq); S.done(cur); }
        if (!has_next) break;
#pragma unroll
        for (int a = 0; a < 2; ++a)
#pragma unroll
            for (int b = 0; b < 2; ++b)
#pragma unroll
                for (int m = 0; m < 4; ++m)
#pragma unroll
                    for (int n = 0; n < 2; ++n) acc[a][b][m][n] = (f32x4){0.f, 0.f, 0.f, 0.f};
        cur = nxt; cA = nA; cB = nB; ++ui;
        if constexpr (ALIGN_EPI) { if (wr == 1) PG8_BAR; }
    }
    PG8_WAIT_V(0);
    if constexpr (!ALIGN_EPI) { if (wr == 0) PG8_BAR; }
    PG8_BAR;
    if constexpr (Epi::AFTER_DRAIN) { E.fused(acc, cur, wr, wc, fr, fq, lds, wid, lane); S.done(cur); }
#undef PG8_SA
#undef PG8_SB
#undef PG8_STAGE
#undef PG8_LDA
#undef PG8_LDB
#undef PG8_MMA
#undef PG8_WAIT_V
#undef PG8_WAIT_L
#undef PG8_BAR
#undef PG8_SCHED
}
}
typedef pg8::bf16_t bf16_t;
typedef pg8::bf16x8 bf16x8;
typedef pg8::f32x4 f32x4;
typedef pg8::u32x4 u32x4;
typedef unsigned u32x2 __attribute__((ext_vector_type(2)));
typedef float f32x2v __attribute__((ext_vector_type(2)));
#define LAS __attribute__((address_space(3)))
constexpr int NW = 8, NT = 512;
constexpr int D = 2048, SEQ = 4096, M = 8192, CTXL = 256, MC = 512, MT = M + MC;
constexpr int DIN = 7168, DFF = 8192, NH = 8;
constexpr int NP = 68;
constexpr int NADA = 6 * D;
constexpr int KSLAB = 16;
constexpr float EPS = 1e-6f;
constexpr size_t MiB = 1u << 20;
constexpr size_t OFF_PART = 0, OFF_MOD = 3 * MiB, OFF_DEC = 4 * MiB, OFF_WIN = 6 * MiB, OFF_WOUT = 34 * MiB, OFF_WUP = 42 * MiB, OFF_WDN = 74 * MiB,
                 OFF_HX = 106 * MiB, OFF_Z = 140 * MiB, OFF_KV = 268 * MiB, WS_END = 336 * MiB;
constexpr int LDS_BYTES = 147456;

struct Args { const float* in[20]; float* out; unsigned char* ws; };

__device__ __forceinline__ float wave_sum(float v) {
#pragma unroll
    for (int o = 1; o < 64; o <<= 1) v += __shfl_xor(v, o);
    return v;
}
__device__ __forceinline__ unsigned f2bf(float f) { unsigned u = __float_as_uint(f); return (u + 0x7fffu + ((u >> 16) & 1u)) >> 16; }
__device__ __forceinline__ unsigned pk2(float lo, float hi) { return f2bf(lo) | (f2bf(hi) << 16); }
__device__ __forceinline__ float bflo(unsigned u) { return __uint_as_float(u << 16); }
__device__ __forceinline__ float bfhi(unsigned u) { return __uint_as_float(u & 0xffff0000u); }
__device__ __forceinline__ float bf1(bf16_t h) { return __uint_as_float((unsigned)h << 16); }
__device__ __forceinline__ float sigm(float x) { return 1.f / (1.f + __expf(-x)); }
__device__ __forceinline__ float silu_(float x) { return x * sigm(x); }

__device__ __forceinline__ void transpose_item(const float* W, int K, int N, bf16_t* WT, float* scr, int item, int lane) {
    const int nblk = N / 32, kb = item / nblk, nb = item % nblk, k0 = 64 * kb, n0 = 32 * nb;
#pragma unroll 8
    for (int i = 0; i < 32; ++i) { const int kk = 2 * i + (lane >> 5); scr[kk * 33 + (lane & 31)] = W[(size_t)(k0 + kk) * N + n0 + (lane & 31)]; }
    asm volatile("s_waitcnt lgkmcnt(0)" ::: "memory");
    const int c = lane & 7;
#pragma unroll
    for (int j = 0; j < 4; ++j) { const int n = (lane >> 3) + 8 * j; const float* s = scr + (8 * c) * 33 + n;
        u32x4 o; o.x = pk2(s[0 * 33], s[1 * 33]); o.y = pk2(s[2 * 33], s[3 * 33]); o.z = pk2(s[4 * 33], s[5 * 33]); o.w = pk2(s[6 * 33], s[7 * 33]);
        *(u32x4*)(WT + (size_t)(n0 + n) * K + k0 + 8 * c) = o; }
    asm volatile("s_waitcnt lgkmcnt(0)" ::: "memory");
}


typedef const __attribute__((address_space(4))) unsigned long long* kargp_t;
__device__ __forceinline__ kargp_t kargp() { kargp_t p = (kargp_t)__builtin_amdgcn_kernarg_segment_ptr(); asm volatile("" : "+s"(p)); return p; }
#define KIN(i) ((const float*)kp[i])
#define PHASE_PTRS \
    kargp_t kp = kargp(); float* out = (float*)kp[20]; unsigned char* ws = (unsigned char*)kp[21]; \
    float* PART = (float*)(ws + OFF_PART); float* MOD = (float*)(ws + OFF_MOD); float* DEC = (float*)(ws + OFF_DEC); \
    bf16_t* WinT = (bf16_t*)(ws + OFF_WIN); bf16_t* WoutT = (bf16_t*)(ws + OFF_WOUT); bf16_t* WupT = (bf16_t*)(ws + OFF_WUP); bf16_t* WdnT = (bf16_t*)(ws + OFF_WDN); \
    bf16_t* HX = (bf16_t*)(ws + OFF_HX); bf16_t* YCAT = HX; bf16_t* Z = (bf16_t*)(ws + OFF_Z); bf16_t* HID = Z; \
    bf16_t* KV = (bf16_t*)(ws + OFF_KV); float* Y = (float*)(ws + OFF_KV); \
    (void)out; (void)PART; (void)MOD; (void)DEC; (void)WinT; (void)WoutT; (void)WupT; (void)WdnT; (void)HX; (void)YCAT; (void)Z; (void)HID; (void)KV; (void)Y;

__device__ __forceinline__ int zrow_of(int p, int b, int j) { return p < 4 ? (M + b * CTXL + p * 64 + j) : (b * SEQ + (p - 4) * 64 + j); }

__global__ void __launch_bounds__(NT, 2) fwd_mega(Args args) {
    extern __shared__ __attribute__((aligned(16))) unsigned char lds[];
    cg::grid_group grid = cg::this_grid();
    const int tid = threadIdx.x, lane = tid & 63, wave = __builtin_amdgcn_readfirstlane(tid >> 6);
    const int G = gridDim.x, bid = blockIdx.x;
    const int gw = bid * NW + wave, NGW = G * NW;
    LAS unsigned char* ldsl = (LAS unsigned char*)lds;

    {
        PHASE_PTRS
        const float* cvec = KIN(1);
        const float* cctx = KIN(3);
        const float* w_ada = KIN(4);
        const float* w_in = KIN(10);
        const float* w_out = KIN(17);
        const float* w_up = KIN(18);
        const float* w_down = KIN(19);
        float* red = (float*)lds;
        for (int bt = bid; bt < 48 * KSLAB; bt += G) {
            const int cgp = bt % 48, ks = bt / 48, k0 = ks * 128 + wave * 16;
            const float* wp = w_ada + (size_t)k0 * NADA + cgp * 256 + lane * 4;
            f32x4 wv[16];
#pragma unroll
            for (int i = 0; i < 16; ++i) wv[i] = *(const f32x4*)(wp + (size_t)i * NADA);
            f32x4 a0 = {0.f, 0.f, 0.f, 0.f}, a1 = a0, a2 = a0;
#pragma unroll
            for (int i = 0; i < 16; ++i) { const float s0 = silu_(cvec[k0 + i]), s1 = silu_(cvec[D + k0 + i]), s2 = silu_(cctx[k0 + i]);
                a0 += wv[i] * s0; a1 += wv[i] * s1; a2 += wv[i] * s2; }
            *(f32x4*)(red + (wave * 3 + 0) * 256 + lane * 4) = a0; *(f32x4*)(red + (wave * 3 + 1) * 256 + lane * 4) = a1; *(f32x4*)(red + (wave * 3 + 2) * 256 + lane * 4) = a2;
            __syncthreads();
            for (int idx = tid; idx < 768; idx += NT) { const int r = idx >> 8, col = idx & 255; float s = 0.f;
#pragma unroll
                for (int w = 0; w < 8; ++w) s += red[(w * 3 + r) * 256 + col];
                PART[(size_t)(ks * 3 + r) * NADA + cgp * 256 + col] = s; }
            __syncthreads();
        }
        float* scr = (float*)(lds + wave * 16384);
        constexpr int I_IN = (D / 64) * (DIN / 32), I_OUT = (D / 64) * (D / 32), I_UP = (D / 64) * (DFF / 32), I_DN = (DFF / 64) * (D / 32);
        for (int it = gw; it < I_IN + I_OUT + I_UP + I_DN; it += NGW) {
            int r = it;
            if (r < I_IN) { transpose_item(w_in, D, DIN, WinT, scr, r, lane); continue; } r -= I_IN;
            if (r < I_OUT) { transpose_item(w_out, D, D, WoutT, scr, r, lane); continue; } r -= I_OUT;
            if (r < I_UP) { transpose_item(w_up, D, DFF, WupT, scr, r, lane); continue; } r -= I_UP;
            transpose_item(w_down, DFF, D, WdnT, scr, r, lane);
        }
    }
    grid.sync();
    {
        PHASE_PTRS
        const float* x = KIN(0);
        const float* ctx = KIN(2);
        const float* b_ada = KIN(5);
        const float* mix_pre_w = KIN(6);
        for (int idx = bid * NT + tid; idx < 3 * NADA; idx += G * NT) { const int r = idx / NADA, n = idx % NADA; float s = b_ada[n];
#pragma unroll
            for (int k = 0; k < KSLAB; ++k) s += PART[(size_t)(k * 3 + r) * NADA + n];
            MOD[idx] = s; }
        float* msh = (float*)lds;
        const int rows_per_blk = M / G;
        const int r0 = bid * rows_per_blk, myb = r0 / SEQ;
        for (int idx = tid; idx < 4 * D; idx += NT) { const int which = idx / (2 * D), n = idx % (2 * D), r = which ? 2 : myb; float s = b_ada[n];
#pragma unroll
            for (int k = 0; k < KSLAB; ++k) s += PART[(size_t)(k * 3 + r) * NADA + n];
            msh[idx] = s; }
        __syncthreads();
        const int nlat = rows_per_blk, nctx = MC / G;
        for (int rr = wave; rr < nlat + nctx; rr += NW) {
            const bool isc = rr >= nlat;
            const int row = isc ? (bid * nctx + rr - nlat) : (r0 + rr);
            const float* xr = isc ? ctx + (size_t)row * D : x + (size_t)row * D;
            const float* ms = msh + (isc ? 2 * D : 0);
            f32x4 v[8]; float ss = 0.f;
#pragma unroll
            for (int j = 0; j < 8; ++j) { v[j] = *(const f32x4*)(xr + lane * 4 + 256 * j); ss += (v[j][0] * v[j][0] + v[j][1] * v[j][1]) + (v[j][2] * v[j][2] + v[j][3] * v[j][3]); }
            const float rstd = rsqrtf(wave_sum(ss) * (1.f / D) + EPS);
            bf16_t* orow = HX + (size_t)(isc ? M + row : row) * D;
#pragma unroll
            for (int j = 0; j < 8; ++j) { const int col = lane * 4 + 256 * j; const f32x4 w = *(const f32x4*)(mix_pre_w + col);
                const f32x4 sh = *(const f32x4*)(ms + col), sc = *(const f32x4*)(ms + D + col);
                f32x4 h = (v[j] * rstd * w) * (sc + 1.f) + sh;
                u32x2 o; o.x = pk2(h[0], h[1]); o.y = pk2(h[2], h[3]); *(u32x2*)(orow + col) = o; }
        }
    }
    grid.sync();
    {
        PHASE_PTRS
        pg8::Gemm g{HX, WinT, MT, DIN, D}; pg8::Sched1 S; S.init(G, bid);
        pg8::EpiBf<0> E{Z, DIN};
        pg8::gemm_phase<pg8::EpiBf<0>, pg8::Sched1, true, true>(ldsl, g, S, E);
    }
    grid.sync();
    {
        PHASE_PTRS
        const float* x = KIN(0);
        const float* conv_w = KIN(11);
        const float* conv_b = KIN(12);
        const float* conv_ln_w = KIN(13);
        const float* conv_ln_b = KIN(14);
        const int c0 = 2 * tid;
        float w0[31], w1[31];
#pragma unroll
        for (int k = 0; k < 31; ++k) { const f32x2v t = *(const f32x2v*)(conv_w + k * 1024 + c0); w0[k] = t.x; w1[k] = t.y; }
        const f32x2v cb = *(const f32x2v*)(conv_b + c0), lw = *(const f32x2v*)(conv_ln_w + c0), lbv = *(const f32x2v*)(conv_ln_b + c0);
        float* red = (float*)lds;
        for (int it = bid; it < 512; it += G) {
            const int b = it >> 8, t0 = (it & 255) * 16;
            float a0[16], a1[16];
#pragma unroll
            for (int j = 0; j < 16; ++j) { a0[j] = 0.f; a1[j] = 0.f; }
#pragma unroll
            for (int ti = 0; ti < 46; ++ti) {
                const int t = t0 - 15 + ti; const bool ok = (t >= 0) && (t < SEQ); const int tc = t < 0 ? 0 : (t >= SEQ ? SEQ - 1 : t);
                const bf16_t* zr = Z + (size_t)(b * SEQ + tc) * DIN + c0;
                const unsigned av = *(const unsigned*)zr, gv = *(const unsigned*)(zr + 1024);
                const float msk = ok ? 1.f : 0.f;
                const float u0 = bflo(av) * sigm(bflo(gv)) * msk, u1 = bfhi(av) * sigm(bfhi(gv)) * msk;
#pragma unroll
                for (int j = 0; j < 16; ++j) { const int k = ti - j; if (k >= 0 && k <= 30) { a0[j] += w0[k] * u0; a1[j] += w1[k] * u1; } }
            }
            __syncthreads();
#pragma unroll
            for (int j = 0; j < 16; ++j) { a0[j] += cb.x; a1[j] += cb.y; const float s = wave_sum(a0[j] + a1[j]); if (lane == 0) red[wave * 16 + j] = s; }
            __syncthreads();
            float mean[16];
#pragma unroll
            for (int j = 0; j < 16; ++j) { float s = 0.f;
#pragma unroll
                for (int w = 0; w < 8; ++w) s += red[w * 16 + j];
                mean[j] = s * (1.f / 1024.f); }
#pragma unroll
            for (int j = 0; j < 16; ++j) { a0[j] -= mean[j]; a1[j] -= mean[j]; const float q = wave_sum(a0[j] * a0[j] + a1[j] * a1[j]); if (lane == 0) red[128 + wave * 16 + j] = q; }
            __syncthreads();
#pragma unroll
            for (int j = 0; j < 16; ++j) { float q = 0.f;
#pragma unroll
                for (int w = 0; w < 8; ++w) q += red[128 + w * 16 + j];
                const float rstd = rsqrtf(q * (1.f / 1024.f) + EPS);
                const float y0 = silu_(a0[j] * rstd * lw.x + lbv.x), y1 = silu_(a1[j] * rstd * lw.y + lbv.y);
                *(unsigned*)(YCAT + (size_t)(b * SEQ + t0 + j) * D + c0) = pk2(y0, y1); }
        }
    }
    {
        PHASE_PTRS
        const float* x = KIN(0);
        const float* lb_logits = KIN(15);
        bf16_t* KT = (bf16_t*)(lds + 4096);
        bf16_t* VT = (bf16_t*)(lds + 4096 + 18432);
        float* TOT = (float*)(lds + 4096 + 36864);
        const int dk = tid & 127, qt = tid >> 7;
        for (int it = bid; it < 32 * NP; it += G) {
            const int h = it & 7, p = (it >> 3) % NP, db = (it >> 3) / NP, d = db >> 1, b = db & 1;
            const int chain = db * 8 + h;
            const float l0 = lb_logits[d * 1024 + h * 128 + dk], l1 = lb_logits[2048 + d * 1024 + h * 128 + dk];
            const float lbd = 1.f / (1.f + __expf(l1 - l0));
            float g[16], kk[16];
            float run = 0.f;
#pragma unroll
            for (int i = 0; i < 16; ++i) { const float zf = bf1(Z[(size_t)zrow_of(p, b, qt * 16 + i) * DIN + 5120 + d * 1024 + h * 128 + dk]);
                const float f = lbd + (1.f - lbd) * sigm(zf); kk[i] = 1.f - f; run += logf(f); g[i] = run; }
            __syncthreads();
            TOT[qt * 128 + dk] = run;
            {
                const int j = tid >> 3, c8 = tid & 7;
                const bf16_t* vp = Z + (size_t)zrow_of(p, b, j) * DIN + 4096 + h * 128 + c8 * 16;
                const u32x4 v0 = *(const u32x4*)vp, v1 = *(const u32x4*)(vp + 8);
                const unsigned vv[8] = {v0.x, v0.y, v0.z, v0.w, v1.x, v1.y, v1.z, v1.w};
#pragma unroll
                for (int e = 0; e < 8; ++e) { VT[(c8 * 16 + 2 * e) * 72 + j] = (bf16_t)(vv[e] & 0xffffu); VT[(c8 * 16 + 2 * e + 1) * 72 + j] = (bf16_t)(vv[e] >> 16); }
            }
            __syncthreads();
            const float T0 = TOT[dk], T1 = TOT[128 + dk], T2 = TOT[256 + dk], T3 = TOT[384 + dk];
            const float tall = (T0 + T1) + (T2 + T3);
            float before = 0.f; if (qt > 0) before += T0; if (qt > 1) before += T1; if (qt > 2) before += T2;
            const float after = tall - before - run;
#pragma unroll
            for (int i = 0; i < 16; ++i) { const float gi = g[i] - (i ? g[i - 1] : 0.f);
                const float e = d == 0 ? (run - g[i]) + after : (g[i] - gi) + before;
                KT[dk * 72 + qt * 16 + i] = (bf16_t)f2bf(kk[i] * __expf(e)); }
            if (qt == 0) DEC[(size_t)(chain * NP + p) * 128 + dk] = __expf(tall);
            __syncthreads();
            {
                const int fr = lane & 15, fq = lane >> 4;
                bf16x8 a[2];
#pragma unroll
                for (int k2 = 0; k2 < 2; ++k2) a[k2] = *(const bf16x8*)(KT + (16 * wave + fr) * 72 + k2 * 32 + fq * 8);
                bf16_t* kvb = KV + (size_t)(chain * NP + p) * 16384;
#pragma unroll
                for (int tl = 0; tl < 8; ++tl) { f32x4 acc = {0.f, 0.f, 0.f, 0.f};
#pragma unroll
                    for (int k2 = 0; k2 < 2; ++k2) { const bf16x8 bb = *(const bf16x8*)(VT + (tl * 16 + fr) * 72 + k2 * 32 + fq * 8); acc = __builtin_amdgcn_mfma_f32_16x16x32_bf16(a[k2], bb, acc, 0, 0, 0); }
                    u32x2 o; o.x = pk2(acc[0], acc[1]); o.y = pk2(acc[2], acc[3]);
                    *(u32x2*)(kvb + (tl * 16 + fr) * 128 + 16 * wave + fq * 4) = o; }
            }
        }
    }
    grid.sync();
    {
        PHASE_PTRS
        const float* x = KIN(0);
        for (int gi = bid * NT + tid; gi < 32 * 4096; gi += G * NT) {
            const int chain = gi >> 12, e4 = (gi & 4095) * 4, d = chain >> 4, dk0 = e4 & 127;
            bf16_t* kvc = KV + (size_t)chain * NP * 16384 + e4; const float* decc = DEC + (size_t)chain * NP * 128 + dk0;
            f32x4 s = {0.f, 0.f, 0.f, 0.f};
#pragma unroll 1
            for (int n0 = 0; n0 < NP; n0 += 17) {
                u32x2 kvv[17]; f32x4 dc[17];
#pragma unroll
                for (int i = 0; i < 17; ++i) { const int n = n0 + i; const int pp = d == 0 ? n : (n < 4 ? 3 - n : 71 - n);
                    kvv[i] = *(const u32x2*)(kvc + (size_t)pp * 16384); dc[i] = *(const f32x4*)(decc + pp * 128); }
#pragma unroll
                for (int i = 0; i < 17; ++i) { const int n = n0 + i; const int pp = d == 0 ? n : (n < 4 ? 3 - n : 71 - n);
                    if (pp >= 4) { u32x2 o; o.x = pk2(s[0], s[1]); o.y = pk2(s[2], s[3]); *(u32x2*)(kvc + (size_t)pp * 16384) = o; }
                    const f32x4 kvf = {bflo(kvv[i].x), bfhi(kvv[i].x), bflo(kvv[i].y), bfhi(kvv[i].y)};
                    s = dc[i] * s + kvf; }
            }
        }
    }
    grid.sync();
    {
        PHASE_PTRS
        const float* x = KIN(0);
        const float* lb_logits = KIN(15);
        const float* rec_norm_w = KIN(16);
        bf16_t* QS = (bf16_t*)(lds);
        bf16_t* KS = (bf16_t*)(lds + 17408);
        bf16_t* QE = (bf16_t*)(lds + 2 * 17408);
        bf16_t* SI = (bf16_t*)(lds + 3 * 17408);
        bf16_t* VT = (bf16_t*)(lds + 3 * 17408 + 34816);
        bf16_t* SC = (bf16_t*)(lds + 3 * 17408 + 34816 + 18432);
        float* TOT = (float*)(lds + 3 * 17408 + 34816 + 18432 + 9216);
        float* SSQ = TOT + 512;
        const int dk = tid & 127, qt = tid >> 7, fr = lane & 15, fq = lane >> 4;
        const int tr = (wave & 3) * 16, hh = wave >> 2;
        for (int it = bid; it < 2 * 64 * 8; it += G) {
            const int h = it & 7, m = (it >> 3) & 63, b = it >> 9;
            const int row0 = b * SEQ + m * 64;
            f32x4 oacc[4];
#pragma unroll
            for (int tl = 0; tl < 4; ++tl) oacc[tl] = (f32x4){0.f, 0.f, 0.f, 0.f};
#pragma unroll 1
            for (int d = 0; d < 2; ++d) {
                const int chain = (d * 2 + b) * 8 + h;
                const float l0 = lb_logits[d * 1024 + h * 128 + dk], l1 = lb_logits[2048 + d * 1024 + h * 128 + dk];
                const float lbd = 1.f / (1.f + __expf(l1 - l0));
                float g[16], kk[16], qq[16];
                float run = 0.f;
#pragma unroll
                for (int i = 0; i < 16; ++i) { const bf16_t* zr = Z + (size_t)(row0 + qt * 16 + i) * DIN + h * 128 + dk;
                    const float zf = bf1(zr[5120 + d * 1024]); qq[i] = silu_(bf1(zr[2048]));
                    const float f = lbd + (1.f - lbd) * sigm(zf); kk[i] = 1.f - f; run += logf(f); g[i] = run; }
                __syncthreads();
                TOT[qt * 128 + dk] = run;
                if (d == 0) {
                    const int j = tid >> 3, c8 = tid & 7;
                    const bf16_t* vp = Z + (size_t)(row0 + j) * DIN + 4096 + h * 128 + c8 * 16;
                    const u32x4 v0 = *(const u32x4*)vp, v1 = *(const u32x4*)(vp + 8);
                    const unsigned vv[8] = {v0.x, v0.y, v0.z, v0.w, v1.x, v1.y, v1.z, v1.w};
#pragma unroll
                    for (int e = 0; e < 8; ++e) { VT[(c8 * 16 + 2 * e) * 72 + j] = (bf16_t)(vv[e] & 0xffffu); VT[(c8 * 16 + 2 * e + 1) * 72 + j] = (bf16_t)(vv[e] >> 16); }
                }
                {
                    const bf16_t* sp = KV + (size_t)(chain * NP + 4 + m) * 16384;
#pragma unroll
                    for (int i = 0; i < 4; ++i) { const int idx = tid + i * NT, r = idx >> 4, c = (idx & 15) * 8; *(u32x4*)(SI + r * 136 + c) = *(const u32x4*)(sp + r * 128 + c); }
                }
                __syncthreads();
                const float T0 = TOT[dk], T1 = TOT[128 + dk], T2 = TOT[256 + dk], T3 = TOT[384 + dk];
                float before = 0.f; if (qt > 0) before += T0; if (qt > 1) before += T1; if (qt > 2) before += T2;
                const float tall = (T0 + T1) + (T2 + T3), after = tall - before - run;
                const float bref = d == 0 ? (T0 + T1) : (T2 + T3);
#pragma unroll
                for (int i = 0; i < 16; ++i) { const float gi = g[i] - (i ? g[i - 1] : 0.f);
                    const float bj = d == 0 ? before + g[i] : (run - g[i] + gi) + after;
                    const int j = qt * 16 + i;
                    QS[j * 136 + dk] = (bf16_t)f2bf(qq[i] * __expf(bj - bref));
                    KS[j * 136 + dk] = (bf16_t)f2bf(kk[i] * __expf(bref - bj));
                    QE[j * 136 + dk] = (bf16_t)f2bf(qq[i] * __expf(bj)); }
                __syncthreads();
                {
                    bf16x8 a[4];
#pragma unroll
                    for (int k4 = 0; k4 < 4; ++k4) a[k4] = *(const bf16x8*)(QS + (tr + fr) * 136 + k4 * 32 + fq * 8);
#pragma unroll
                    for (int st = 0; st < 2; ++st) { const int s0 = (hh * 2 + st) * 16; f32x4 acc = {0.f, 0.f, 0.f, 0.f};
#pragma unroll
                        for (int k4 = 0; k4 < 4; ++k4) { const bf16x8 bb = *(const bf16x8*)(KS + (s0 + fr) * 136 + k4 * 32 + fq * 8); acc = __builtin_amdgcn_mfma_f32_16x16x32_bf16(a[k4], bb, acc, 0, 0, 0); }
#pragma unroll
                        for (int jj = 0; jj < 4; ++jj) { const int t = tr + fq * 4 + jj, s = s0 + fr; const bool keep = d == 0 ? (s <= t) : (s >= t);
                            SC[t * 72 + s] = (bf16_t)f2bf(keep ? acc[jj] : 0.f); } }
                }
                __syncthreads();
                {
                    bf16x8 aS[2], aE[4];
#pragma unroll
                    for (int k2 = 0; k2 < 2; ++k2) aS[k2] = *(const bf16x8*)(SC + (tr + fr) * 72 + k2 * 32 + fq * 8);
#pragma unroll
                    for (int k4 = 0; k4 < 4; ++k4) aE[k4] = *(const bf16x8*)(QE + (tr + fr) * 136 + k4 * 32 + fq * 8);
#pragma unroll
                    for (int tl = 0; tl < 4; ++tl) { const int dv0 = (hh * 4 + tl) * 16;
#pragma unroll
                        for (int k2 = 0; k2 < 2; ++k2) { const bf16x8 bb = *(const bf16x8*)(VT + (dv0 + fr) * 72 + k2 * 32 + fq * 8); oacc[tl] = __builtin_amdgcn_mfma_f32_16x16x32_bf16(aS[k2], bb, oacc[tl], 0, 0, 0); }
#pragma unroll
                        for (int k4 = 0; k4 < 4; ++k4) { const bf16x8 bb = *(const bf16x8*)(SI + (dv0 + fr) * 136 + k4 * 32 + fq * 8); oacc[tl] = __builtin_amdgcn_mfma_f32_16x16x32_bf16(aE[k4], bb, oacc[tl], 0, 0, 0); } }
                }
            }
            float ssq[4];
#pragma unroll
            for (int jj = 0; jj < 4; ++jj) { float s = 0.f;
#pragma unroll
                for (int tl = 0; tl < 4; ++tl) s += oacc[tl][jj] * oacc[tl][jj];
                s += __shfl_xor(s, 1); s += __shfl_xor(s, 2); s += __shfl_xor(s, 4); s += __shfl_xor(s, 8); ssq[jj] = s; }
            if (fr == 0) {
#pragma unroll
                for (int jj = 0; jj < 4; ++jj) SSQ[hh * 64 + tr + fq * 4 + jj] = ssq[jj]; }
            __syncthreads();
#pragma unroll
            for (int jj = 0; jj < 4; ++jj) { const int t = tr + fq * 4 + jj; const float rstd = rsqrtf((SSQ[t] + SSQ[64 + t]) * (1.f / 128.f) + EPS);
#pragma unroll
                for (int tl = 0; tl < 4; ++tl) { const int dv = (hh * 4 + tl) * 16 + fr;
                    const float gz = bf1(Z[(size_t)(row0 + t) * DIN + 3072 + h * 128 + dv]);
                    const float o = oacc[tl][jj] * rstd * rec_norm_w[h * 128 + dv] * silu_(gz);
                    YCAT[(size_t)(row0 + t) * D + 1024 + h * 128 + dv] = (bf16_t)f2bf(o); } }
        }
    }
    grid.sync();
    {
        PHASE_PTRS
        pg8::Gemm g{YCAT, WoutT, M, D, D}; pg8::StaticOrder S; S.init(M, D, G, bid);
        pg8::EpiF32 E{Y, D};
        pg8::gemm_phase<pg8::EpiF32, pg8::StaticOrder, true, true>(ldsl, g, S, E);
    }
    grid.sync();
    {
        PHASE_PTRS
        const float* x = KIN(0);
        const float* mix_post_w = KIN(7);
        const float* mlp_pre_w = KIN(8);
        for (int row = gw; row < M; row += NGW) {
            const int b = row / SEQ; const float* md = MOD + (size_t)b * NADA;
            const float* yr = Y + (size_t)row * D; const float* xr = x + (size_t)row * D; float* orow = out + (size_t)row * D; bf16_t* hrow = HX + (size_t)row * D;
            f32x4 v[8]; float ss = 0.f;
#pragma unroll
            for (int j = 0; j < 8; ++j) { v[j] = *(const f32x4*)(yr + lane * 4 + 256 * j); ss += (v[j][0] * v[j][0] + v[j][1] * v[j][1]) + (v[j][2] * v[j][2] + v[j][3] * v[j][3]); }
            const float rstd = rsqrtf(wave_sum(ss) * (1.f / D) + EPS);
            float ss2 = 0.f;
#pragma unroll
            for (int j = 0; j < 8; ++j) { const int col = lane * 4 + 256 * j;
                const f32x4 xv = *(const f32x4*)(xr + col), w = *(const f32x4*)(mix_post_w + col), g1 = *(const f32x4*)(md + 2 * D + col);
                v[j] = xv + g1 * (v[j] * rstd * w);
                *(f32x4*)(orow + col) = v[j];
                ss2 += (v[j][0] * v[j][0] + v[j][1] * v[j][1]) + (v[j][2] * v[j][2] + v[j][3] * v[j][3]); }
            const float rstd2 = rsqrtf(wave_sum(ss2) * (1.f / D) + EPS);
#pragma unroll
            for (int j = 0; j < 8; ++j) { const int col = lane * 4 + 256 * j;
                const f32x4 w = *(const f32x4*)(mlp_pre_w + col), sh = *(const f32x4*)(md + 3 * D + col), sc = *(const f32x4*)(md + 4 * D + col);
                const f32x4 hv = (v[j] * rstd2 * w) * (sc + 1.f) + sh;
                u32x2 o; o.x = pk2(hv[0], hv[1]); o.y = pk2(hv[2], hv[3]); *(u32x2*)(hrow + col) = o; }
        }
    }
    grid.sync();
    {
        PHASE_PTRS
        pg8::Gemm g{HX, WupT, M, DFF, D}; pg8::StaticOrder S; S.init(M, DFF, G, bid);
        pg8::EpiBf<2> E{HID, DFF};
        pg8::gemm_phase<pg8::EpiBf<2>, pg8::StaticOrder, true, true>(ldsl, g, S, E);
    }
    grid.sync();
    {
        PHASE_PTRS
        pg8::Gemm g{HID, WdnT, M, D, DFF}; pg8::StaticOrder S; S.init(M, D, G, bid);
        pg8::EpiF32 E{Y, D};
        pg8::gemm_phase<pg8::EpiF32, pg8::StaticOrder, true, true>(ldsl, g, S, E);
    }
    grid.sync();
    {
        PHASE_PTRS
        const float* mlp_post_w = KIN(9);
        for (int row = gw; row < M; row += NGW) {
            const int b = row / SEQ; const float* md = MOD + (size_t)b * NADA;
            const float* yr = Y + (size_t)row * D; float* orow = out + (size_t)row * D;
            f32x4 v[8]; float ss = 0.f;
#pragma unroll
            for (int j = 0; j < 8; ++j) { v[j] = *(const f32x4*)(yr + lane * 4 + 256 * j); ss += (v[j][0] * v[j][0] + v[j][1] * v[j][1]) + (v[j][2] * v[j][2] + v[j][3] * v[j][3]); }
            const float rstd = rsqrtf(wave_sum(ss) * (1.f / D) + EPS);
#pragma unroll
            for (int j = 0; j < 8; ++j) { const int col = lane * 4 + 256 * j;
                const f32x4 xv = *(const f32x4*)(orow + col), w = *(const f32x4*)(mlp_post_w + col), g2 = *(const f32x4*)(md + 5 * D + col);
                *(f32x4*)(orow + col) = xv + g2 * (v[j] * rstd * w); }
        }
    }
}

extern "C" void kernel_launch(void* const* d_in, const int* in_sizes, int n_in, void* d_out, int out_size, void* d_ws, size_t ws_size, hipStream_t stream) {
    static int grid = 0;
    if (grid == 0) {
        if (n_in != 20 || out_size != M * D || ws_size < WS_END) { fprintf(stderr, "kernel_launch: unexpected shapes (n_in %d out %d ws %zu)\n", n_in, out_size, ws_size); grid = -1; return; }
        int dev = 0, cus = 0, per_cu = 0;
        hipGetDevice(&dev); hipDeviceGetAttribute(&cus, hipDeviceAttributeMultiprocessorCount, dev);
        hipFuncSetAttribute((const void*)fwd_mega, hipFuncAttributeMaxDynamicSharedMemorySize, LDS_BYTES);
        hipOccupancyMaxActiveBlocksPerMultiprocessor(&per_cu, (const void*)fwd_mega, NT, LDS_BYTES);
        if (per_cu < 1) { fprintf(stderr, "kernel_launch: occupancy query says %d blocks per CU\n", per_cu); per_cu = 1; }
        grid = cus * 1;
        if (grid > 256) grid = 256;
        (void)hipGetLastError();
    }
    if (grid < 0) return;
    Args a{};
    for (int i = 0; i < 20; ++i) a.in[i] = (const float*)d_in[i];
    a.out = (float*)d_out; a.ws = (unsigned char*)d_ws;
    void* kargs[] = {&a};
    hipError_t e = hipLaunchCooperativeKernel((const void*)fwd_mega, dim3(grid), dim3(NT), kargs, LDS_BYTES, stream);
    if (e != hipSuccess) fprintf(stderr, "cooperative launch failed: %s (grid %d)\n", hipGetErrorString(e), grid);
}
```

```cpp
#include <hip/hip_runtime.h>
#include <hip/hip_cooperative_groups.h>
#include <cstdio>
#include <cstdint>
namespace cg = cooperative_groups;
namespace pg8 {
#define PG8_LAS __attribute__((address_space(3)))
typedef unsigned short bf16_t;
typedef short bf16x8 __attribute__((ext_vector_type(8)));
typedef float f32x4 __attribute__((ext_vector_type(4)));
typedef unsigned u32x4 __attribute__((ext_vector_type(4)));
constexpr int BM = 256, BK = 64, HALF = 128, HTB = HALF * BK * 2  , STAGE_BYTES = 8 * HTB, NXCD = 8, WGM = 8;

__host__ __device__ __forceinline__ int lds_byte(int r, int c) { const int st = (r >> 4) * 2 + (c >> 5), rr = r & 15, cc = c & 31, ob = rr * 64 + cc * 2; return st * 1024 + (ob ^ (((ob >> 9) & 1) << 5)); }
__host__ __device__ __forceinline__ void stage_rc(int b, int& R, int& C) { const int st = b / 1024, sb = b % 1024, swz = sb ^ (((sb >> 9) & 1) << 5); R = (st >> 1) * 16 + swz / 64; C = (st & 1) * 32 + (swz % 64) / 2; }
__host__ __device__ __forceinline__ int perm32(int rho) { const int n = rho >> 4, i = rho & 15; return 8 * (i >> 2) + 4 * n + (i & 3); }

struct Unit { int pm, pn; };
struct Gemm { const bf16_t* A; const bf16_t* Bt; int M, N, K; };

struct StaticOrder {
    int nM, nN, nwg, G, c;
    __host__ __device__ void init(int M, int N, int G_, int c_) { nM = M / BM; nN = N / BM; nwg = nM * nN; G = G_; c = c_; }
    __host__ __device__ bool next(int i, Unit& u) const {
        const long L = (long)i * G + c; if (L >= nwg) return false;
        int wgid = (int)L; { const int q = nwg / NXCD, r = nwg % NXCD, xcd = wgid % NXCD, off = wgid / NXCD; wgid = (xcd < r ? xcd * (q + 1) : r * (q + 1) + (xcd - r) * q) + off; }
        const int nig = WGM * nN, gid = wgid / nig, fm = gid * WGM, gsz = (nM - fm) < WGM ? (nM - fm) : WGM;
        u.pm = fm + ((wgid % nig) % gsz); u.pn = (wgid % nig) / gsz; return true;
    }
    __device__ __forceinline__ void a_ready(const Unit&) const {}
    __device__ __forceinline__ void done(const Unit&) const {}
};

__device__ __forceinline__ unsigned cvt_pk_bf16(float lo, float hi) { unsigned r; asm volatile("v_cvt_pk_bf16_f32 %0, %1, %2" : "=v"(r) : "v"(lo), "v"(hi)); return r; }
typedef float f32x2 __attribute__((ext_vector_type(2)));
template <int ACT  > struct EpiBf {
    static constexpr bool PERM = true, AFTER_DRAIN = false;
    bf16_t* O; int ldc;
    __device__ __forceinline__ void operator()(const f32x4 (&acc)[2][2][4][2], const Unit& u, int wr, int wc, int fr, int fq) const {
        const int row0 = u.pm * BM + wr * 64 + fr, col0 = u.pn * BM + wc * 32 + 8 * fq;
#pragma unroll
        for (int ai = 0; ai < 2; ++ai)
#pragma unroll
            for (int m = 0; m < 4; ++m) { bf16_t* rowp = O + (size_t)(row0 + ai * HALF + m * 16) * ldc + col0;
#pragma unroll
                for (int bj = 0; bj < 2; ++bj) { f32x4 v0 = acc[ai][bj][m][0], v1 = acc[ai][bj][m][1];
                    if (ACT == 2) {
#pragma unroll
                        for (int e = 0; e < 4; ++e) { float a = fmaxf(v0[e], 0.f), b = fmaxf(v1[e], 0.f); v0[e] = a * a; v1[e] = b * b; } }
                    u32x4 w; w.x = cvt_pk_bf16(v0[0], v0[1]); w.y = cvt_pk_bf16(v0[2], v0[3]); w.z = cvt_pk_bf16(v1[0], v1[1]); w.w = cvt_pk_bf16(v1[2], v1[3]);
                    *(u32x4*)(rowp + bj * HALF) = w; } }
    }
};
struct EpiF32 {
    static constexpr bool PERM = false, AFTER_DRAIN = false;
    float* O; int ldc;
    __device__ __forceinline__ void operator()(const f32x4 (&acc)[2][2][4][2], const Unit& u, int wr, int wc, int fr, int fq) const {
        const int col0 = u.pn * BM + wc * 32 + 4 * fq;
#pragma unroll
        for (int ai = 0; ai < 2; ++ai)
#pragma unroll
            for (int m = 0; m < 4; ++m) { float* rowp = O + (size_t)(u.pm * BM + ai * HALF + wr * 64 + m * 16 + fr) * ldc + col0;
#pragma unroll
                for (int bj = 0; bj < 2; ++bj)
#pragma unroll
                    for (int n = 0; n < 2; ++n) *(f32x4*)(rowp + bj * HALF + n * 16) = acc[ai][bj][m][n]; }
    }
};
struct Sched1 {
    StaticOrder so; int G, c;
    __device__ void init(int G_, int c_) { so.init(8192, 7168, G_, c_); G = G_; c = c_; }
    __device__ bool next(int i, Unit& u) const {
        if (so.next(i, u)) return true;
        const long L = (long)i * G + c - so.nwg; if (L < 0 || L >= 24) return false;
        u.pm = 32 + (int)(L & 1); u.pn = 16 + (int)(L >> 1); return true;
    }
    __device__ __forceinline__ void a_ready(const Unit&) const {}
    __device__ __forceinline__ void done(const Unit&) const {}
};
template <class Epi, class Sched, bool ALIGN_EPI = false, bool SP2 = false>
__device__ __forceinline__ void gemm_phase(PG8_LAS unsigned char* lds, const Gemm g, const Sched& S, const Epi& E) {
    int tid_ = threadIdx.x; asm volatile("" : "+v"(tid_));
    const int tid = tid_, wid = __builtin_amdgcn_readfirstlane(tid >> 6), lane = tid & 63, wr = wid >> 2, wc = wid & 3, fr = lane & 15, fq = lane >> 4;
    const int K = g.K, nt = K / BK;
    unsigned voffA[2], voffB[2];
#pragma unroll
    for (int i = 0; i < 2; ++i) { int R, C; stage_rc(tid * 16 + i * 8192, R, C); const int Rb = Epi::PERM ? ((R & ~31) + perm32(R & 31)) : R;
        voffA[i] = (unsigned)(R * K + C) * 2u; voffB[i] = (unsigned)(Rb * K + C) * 2u; }
    const size_t kstep = (size_t)(BK * 2);
    const size_t hstep = (size_t)HALF * K * 2;
    const size_t tstep = 2 * hstep;
    const unsigned ldsw = (unsigned)wid * 1024u;
    const int aoff = lds_byte(wr * 64 + fr, fq * 8), boff = lds_byte(wc * 32 + fr, fq * 8);
#define PG8_SA(b, h) (((b) * 2 + (h)) * HTB)
#define PG8_SB(b, h) ((4 + (b) * 2 + (h)) * HTB)
#define PG8_STAGE(bufoff, gbase, voff) do { _Pragma("unroll") for (int _i = 0; _i < 2; ++_i) \
        __builtin_amdgcn_global_load_lds((const unsigned*)((const char*)(gbase) + (voff)[_i]), (PG8_LAS unsigned*)(lds + (bufoff) + ldsw + _i * 8192), 16, 0, 0); } while (0)
#define PG8_LDA(dst, b, h) do { _Pragma("unroll") for (int m = 0; m < 4; ++m) _Pragma("unroll") for (int k = 0; k < 2; ++k) dst[m][k] = *(const PG8_LAS bf16x8*)(lds + PG8_SA(b, h) + aoff + m * 2048 + k * 1024); } while (0)
#define PG8_LDB(dst, b, h) do { _Pragma("unroll") for (int n = 0; n < 2; ++n) _Pragma("unroll") for (int k = 0; k < 2; ++k) dst[n][k] = *(const PG8_LAS bf16x8*)(lds + PG8_SB(b, h) + boff + n * 2048 + k * 1024); } while (0)
#define PG8_MMA(ai, bj, At, Bt) do { __builtin_amdgcn_s_setprio(1); _Pragma("unroll") for (int m = 0; m < 4; ++m) _Pragma("unroll") for (int n = 0; n < 2; ++n) _Pragma("unroll") for (int k = 0; k < 2; ++k) \
        acc[ai][bj][m][n] = __builtin_amdgcn_mfma_f32_16x16x32_bf16(Bt[n][k], At[m][k], acc[ai][bj][m][n], 0, 0, 0); __builtin_amdgcn_s_setprio(0); } while (0)
#define PG8_WAIT_V(n) asm volatile("s_waitcnt vmcnt(" #n ")" ::: "memory")
#define PG8_WAIT_L(n) asm volatile("s_waitcnt lgkmcnt(" #n ")" ::: "memory")
#define PG8_BAR __builtin_amdgcn_s_barrier()
#define PG8_SCHED __builtin_amdgcn_sched_barrier(0)
    Unit cur, nxt; int ui = 0;
    if (!S.next(0, cur)) return;
    f32x4 acc[2][2][4][2];
#pragma unroll
    for (int a = 0; a < 2; ++a)
#pragma unroll
        for (int b = 0; b < 2; ++b)
#pragma unroll
            for (int m = 0; m < 4; ++m)
#pragma unroll
                for (int n = 0; n < 2; ++n) acc[a][b][m][n] = (f32x4){0.f, 0.f, 0.f, 0.f};
    bf16x8 At[4][2], B0[2][2], B1[2][2];
    const char* cA = (const char*)g.A + (size_t)cur.pm * tstep; const char* cB = (const char*)g.Bt + (size_t)cur.pn * tstep;
    S.a_ready(cur);
    if constexpr (SP2) {
        PG8_STAGE(PG8_SB(0, 0), cB, voffB); PG8_STAGE(PG8_SB(0, 1), cB + hstep, voffB); PG8_STAGE(PG8_SA(0, 0), cA, voffA); PG8_STAGE(PG8_SA(0, 1), cA + hstep, voffA);
        if (wr == 1) PG8_BAR;
        PG8_WAIT_V(2); PG8_BAR;
        PG8_STAGE(PG8_SB(1, 0), cB + kstep, voffB); PG8_STAGE(PG8_SA(1, 0), cA + kstep, voffA); PG8_STAGE(PG8_SB(1, 1), cB + hstep + kstep, voffB);
        PG8_WAIT_V(6); PG8_BAR;
    } else {
        PG8_STAGE(PG8_SB(0, 0), cB, voffB); PG8_STAGE(PG8_SA(0, 0), cA, voffA); PG8_STAGE(PG8_SB(0, 1), cB + hstep, voffB); PG8_STAGE(PG8_SA(0, 1), cA + hstep, voffA);
        if (wr == 1) PG8_BAR;
        PG8_WAIT_V(4); PG8_BAR;
        PG8_STAGE(PG8_SB(1, 0), cB + kstep, voffB); PG8_STAGE(PG8_SA(1, 0), cA + kstep, voffA); PG8_STAGE(PG8_SB(1, 1), cB + hstep + kstep, voffB);
        PG8_WAIT_V(6); PG8_BAR;
    }
    for (;;) {
        const bool has_next = S.next(ui + 1, nxt);
        const char* nA = has_next ? (const char*)g.A + (size_t)nxt.pm * tstep : cA; const char* nB = has_next ? (const char*)g.Bt + (size_t)nxt.pn * tstep : cB;
        for (int t = 0; t < nt; t += 2) {
            const bool last = (t == nt - 2);
            const char* a1 = cA + (size_t)(t + 1) * kstep;
            const char* a2 = last ? nA : cA + (size_t)(t + 2) * kstep; const char* b2 = last ? nB : cB + (size_t)(t + 2) * kstep;
            const char* a3 = a2 + kstep; const char* b3 = b2 + kstep;
            if (last && has_next) S.a_ready(nxt);
            if constexpr (SP2) {
            PG8_LDB(B0, 0, 0); PG8_LDB(B1, 0, 1); PG8_SCHED; PG8_LDA(At, 0, 0); PG8_STAGE(PG8_SA(1, 1), a1 + hstep, voffA);
            PG8_WAIT_V(8); PG8_WAIT_L(0); PG8_BAR; PG8_MMA(0, 0, At, B0); PG8_MMA(0, 1, At, B1); PG8_BAR; PG8_SCHED;
            PG8_LDA(At, 0, 1); PG8_STAGE(PG8_SB(0, 0), b2, voffB); PG8_STAGE(PG8_SB(0, 1), b2 + hstep, voffB); PG8_STAGE(PG8_SA(0, 0), a2, voffA);
            PG8_WAIT_V(8); PG8_WAIT_L(0); PG8_BAR; PG8_MMA(1, 0, At, B0); PG8_MMA(1, 1, At, B1); PG8_BAR; PG8_SCHED;
            PG8_LDB(B0, 1, 0); PG8_LDB(B1, 1, 1); PG8_SCHED; PG8_LDA(At, 1, 0); PG8_STAGE(PG8_SA(0, 1), a2 + hstep, voffA);
            PG8_WAIT_V(8); PG8_WAIT_L(0); PG8_BAR; PG8_MMA(0, 0, At, B0); PG8_MMA(0, 1, At, B1); PG8_BAR; PG8_SCHED;
            PG8_LDA(At, 1, 1); PG8_STAGE(PG8_SB(1, 0), b3, voffB); PG8_STAGE(PG8_SB(1, 1), b3 + hstep, voffB); PG8_STAGE(PG8_SA(1, 0), a3, voffA);
            PG8_WAIT_V(8); PG8_WAIT_L(0); PG8_BAR; PG8_MMA(1, 0, At, B0); PG8_MMA(1, 1, At, B1); PG8_BAR; PG8_SCHED;
            } else {
            PG8_LDB(B0, 0, 0); PG8_SCHED; PG8_LDA(At, 0, 0); PG8_STAGE(PG8_SA(1, 1), a1 + hstep, voffA);
            PG8_WAIT_L(8); PG8_BAR; PG8_WAIT_L(0); PG8_MMA(0, 0, At, B0); PG8_BAR; PG8_SCHED;
            PG8_LDB(B1, 0, 1); PG8_STAGE(PG8_SB(0, 0), b2, voffB);
            PG8_BAR; PG8_WAIT_L(0); PG8_MMA(0, 1, At, B1); PG8_BAR;
            PG8_LDA(At, 0, 1); PG8_STAGE(PG8_SA(0, 0), a2, voffA);
            PG8_BAR; PG8_WAIT_L(0); PG8_MMA(1, 0, At, B0); PG8_BAR; PG8_SCHED;
            PG8_STAGE(PG8_SB(0, 1), b2 + hstep, voffB);
            PG8_WAIT_V(6); PG8_BAR; PG8_MMA(1, 1, At, B1); PG8_BAR;
            PG8_LDB(B0, 1, 0); PG8_SCHED; PG8_LDA(At, 1, 0); PG8_STAGE(PG8_SA(0, 1), a2 + hstep, voffA);
            PG8_WAIT_L(8); PG8_BAR; PG8_WAIT_L(0); PG8_MMA(0, 0, At, B0); PG8_BAR; PG8_SCHED;
            PG8_LDB(B1, 1, 1); PG8_STAGE(PG8_SB(1, 0), b3, voffB);
            PG8_BAR; PG8_WAIT_L(0); PG8_MMA(0, 1, At, B1); PG8_BAR;
            PG8_LDA(At, 1, 1); PG8_STAGE(PG8_SA(1, 0), a3, voffA);
            PG8_BAR; PG8_WAIT_L(0); PG8_MMA(1, 0, At, B0); PG8_BAR; PG8_SCHED;
            PG8_STAGE(PG8_SB(1, 1), b3 + hstep, voffB);
            PG8_WAIT_V(6); PG8_BAR; PG8_MMA(1, 1, At, B1); PG8_BAR;
            }
        }
        if constexpr (ALIGN_EPI) { if (wr == 0) PG8_BAR; }
        if constexpr (!Epi::AFTER_DRAIN) { E(acc, cur, wr, wc, fr, fq); S.done(cur); }
        if (!has_next) break;
#pragma unroll
        for (int a = 0; a < 2; ++a)
#pragma unroll
            for (int b = 0; b < 2; ++b)
#pragma unroll
                for (int m = 0; m < 4; ++m)
#pragma unroll
                    for (int n = 0; n < 2; ++n) acc[a][b][m][n] = (f32x4){0.f, 0.f, 0.f, 0.f};
        cur = nxt; cA = nA; cB = nB; ++ui;
        if constexpr (ALIGN_EPI) { if (wr == 1) PG8_BAR; }
    }
    PG8_WAIT_V(0);
    if constexpr (!ALIGN_EPI) { if (wr == 0) PG8_BAR; }
    PG8_BAR;
    if constexpr (Epi::AFTER_DRAIN) { E.fused(acc, cur, wr, wc, fr, fq, lds, wid, lane); S.done(cur); }
#undef PG8_SA
#undef PG8_SB
#undef PG8_STAGE
#undef PG8_LDA
#undef PG8_LDB
#undef PG8_MMA
#undef PG8_WAIT_V
#undef PG8_WAIT_L
#undef PG8_BAR
#undef PG8_SCHED
}
}
typedef pg8::bf16_t bf16_t;
typedef pg8::bf16x8 bf16x8;
typedef pg8::f32x4 f32x4;
typedef pg8::u32x4 u32x4;
typedef unsigned u32x2 __attribute__((ext_vector_type(2)));
typedef float f32x2v __attribute__((ext_vector_type(2)));
#define LAS __attribute__((address_space(3)))
constexpr int NW = 8, NT = 512;
constexpr int D = 2048, SEQ = 4096, M = 8192, CTXL = 256, MC = 512, MT = M + MC;
constexpr int DIN = 7168, DFF = 8192, NH = 8;
constexpr int NP = 68;
constexpr int NADA = 6 * D;
constexpr int KSLAB = 16;
constexpr float EPS = 1e-6f;
constexpr size_t MiB = 1u << 20;
constexpr size_t OFF_CTL = 5 * MiB + 512 * 1024, CTL_BYTES = 16384;
constexpr size_t OFF_PART = 0, OFF_MOD = 3 * MiB, OFF_DEC = 4 * MiB, OFF_WIN = 6 * MiB, OFF_WOUT = 34 * MiB, OFF_WUP = 42 * MiB, OFF_WDN = 74 * MiB,
                 OFF_HX = 106 * MiB, OFF_Z = 140 * MiB, OFF_KV = 268 * MiB, WS_END = 336 * MiB;
constexpr int LDS_BYTES = 147456;

struct Args { const float* in[20]; float* out; unsigned char* ws; };

__device__ __forceinline__ float wave_sum(float v) {
#pragma unroll
    for (int o = 1; o < 64; o <<= 1) v += __shfl_xor(v, o);
    return v;
}
__device__ __forceinline__ unsigned f2bf(float f) { unsigned u = __float_as_uint(f); return (u + 0x7fffu + ((u >> 16) & 1u)) >> 16; }
__device__ __forceinline__ unsigned pk2(float lo, float hi) { return f2bf(lo) | (f2bf(hi) << 16); }
__device__ __forceinline__ float bflo(unsigned u) { return __uint_as_float(u << 16); }
__device__ __forceinline__ float bfhi(unsigned u) { return __uint_as_float(u & 0xffff0000u); }
__device__ __forceinline__ float bf1(bf16_t h) { return __uint_as_float((unsigned)h << 16); }
__device__ __forceinline__ float sigm(float x) { return 1.f / (1.f + __expf(-x)); }
__device__ __forceinline__ float silu_(float x) { return x * sigm(x); }

__device__ __forceinline__ void transpose_item(const float* W, int K, int N, bf16_t* WT, float* scr, int item, int lane) {
    const int nblk = N / 32, kb = item / nblk, nb = item % nblk, k0 = 64 * kb, n0 = 32 * nb;
#pragma unroll 8
    for (int i = 0; i < 32; ++i) { const int kk = 2 * i + (lane >> 5); scr[kk * 33 + (lane & 31)] = W[(size_t)(k0 + kk) * N + n0 + (lane & 31)]; }
    asm volatile("s_waitcnt lgkmcnt(0)" ::: "memory");
    const int c = lane & 7;
#pragma unroll
    for (int j = 0; j < 4; ++j) { const int n = (lane >> 3) + 8 * j; const float* s = scr + (8 * c) * 33 + n;
        u32x4 o; o.x = pk2(s[0 * 33], s[1 * 33]); o.y = pk2(s[2 * 33], s[3 * 33]); o.z = pk2(s[4 * 33], s[5 * 33]); o.w = pk2(s[6 * 33], s[7 * 33]);
        *(u32x4*)(WT + (size_t)(n0 + n) * K + k0 + 8 * c) = o; }
    asm volatile("s_waitcnt lgkmcnt(0)" ::: "memory");
}


typedef const __attribute__((address_space(4))) unsigned long long* kargp_t;
__device__ __forceinline__ kargp_t kargp() { kargp_t p = (kargp_t)__builtin_amdgcn_kernarg_segment_ptr(); asm volatile("" : "+s"(p)); return p; }
#define KIN(i) ((const float*)kp[i])
#define PHASE_PTRS \
    kargp_t kp = kargp(); float* out = (float*)kp[20]; unsigned char* ws = (unsigned char*)kp[21]; \
    float* PART = (float*)(ws + OFF_PART); float* MOD = (float*)(ws + OFF_MOD); float* DEC = (float*)(ws + OFF_DEC); \
    bf16_t* WinT = (bf16_t*)(ws + OFF_WIN); bf16_t* WoutT = (bf16_t*)(ws + OFF_WOUT); bf16_t* WupT = (bf16_t*)(ws + OFF_WUP); bf16_t* WdnT = (bf16_t*)(ws + OFF_WDN); \
    bf16_t* HX = (bf16_t*)(ws + OFF_HX); bf16_t* YCAT = HX; bf16_t* Z = (bf16_t*)(ws + OFF_Z); bf16_t* HID = Z; \
    bf16_t* KV = (bf16_t*)(ws + OFF_KV); float* Y = (float*)(ws + OFF_KV); \
    (void)out; (void)PART; (void)MOD; (void)DEC; (void)WinT; (void)WoutT; (void)WupT; (void)WdnT; (void)HX; (void)YCAT; (void)Z; (void)HID; (void)KV; (void)Y;

__device__ __forceinline__ int zrow_of(int p, int b, int j) { return p < 4 ? (M + b * CTXL + p * 64 + j) : (b * SEQ + (p - 4) * 64 + j); }

#define XB_TMO      128
#define XB_XCNT(j)  (256  + 64 * (j))
#define XB_XSUB(j)  (1280 + 64 * (j))
#define XB_XGEN(j)  (2304 + 64 * (j))
#define XB_TOP      3328
#define XB_TOPGEN   3392
#define XCD_BAR_WORDS 3456
#define XB_SPIN_CAP (1u << 18)

__device__ __forceinline__ unsigned xb_ld(unsigned* p)              { return __hip_atomic_load(p, __ATOMIC_RELAXED, __HIP_MEMORY_SCOPE_AGENT); }
__device__ __forceinline__ unsigned xb_add(unsigned* p, unsigned v) { return __hip_atomic_fetch_add(p, v, __ATOMIC_RELAXED, __HIP_MEMORY_SCOPE_AGENT); }
__device__ __forceinline__ unsigned xb_xcc_id() { return (unsigned)__builtin_amdgcn_s_getreg((3 << 11) | 20) & 0xFu; }
#define XB_SPIN(cond, bar) do { unsigned _sp = 0; while (cond) { __builtin_amdgcn_s_sleep(1); \
    if ((++_sp & 255u) == 0u) { if (xb_ld(&(bar)[XB_TMO])) break; if (_sp > XB_SPIN_CAP) { atomicAdd(&(bar)[XB_TMO], 1u); break; } } } } while (0)

struct XcdBarrier {
    unsigned* bar; unsigned x;
    volatile LAS unsigned* st;
};

__device__ __forceinline__ XcdBarrier xcd_barrier_post(unsigned* bar, volatile LAS unsigned* st) {
    XcdBarrier b; b.bar = bar; b.x = xb_xcc_id(); b.st = st;
    if (threadIdx.x == 0) (void)xb_add(&bar[XB_XCNT(b.x)], 1u);
    return b;
}
__device__ __forceinline__ void xcd_barrier_complete(unsigned* bar, unsigned x, unsigned& nloc, unsigned& nx) {
    const unsigned G = gridDim.x * gridDim.y * gridDim.z;
    unsigned sum, cnt, mine, sp = 0u;
    for (;;) {
        sum = 0u; cnt = 0u; mine = 0u;
#pragma unroll
        for (unsigned j = 0; j < 16; ++j) { const unsigned c = xb_ld(&bar[XB_XCNT(j)]); sum += c; cnt += (c > 0u) ? 1u : 0u; mine = (j == x) ? c : mine; }
        if (sum == G) break;
        __builtin_amdgcn_s_sleep(1);
        if ((++sp & 255u) == 0u) { if (xb_ld(&bar[XB_TMO])) break; if (sp > XB_SPIN_CAP) { atomicAdd(&bar[XB_TMO], 1u); break; } }
    }
    nloc = mine > 0u ? mine : 1u; nx = cnt > 0u ? cnt : 1u;
}

__device__ __forceinline__ void xcd_barrier(const XcdBarrier& b) {
    asm volatile("s_waitcnt vmcnt(0)" ::: "memory");
    __syncthreads();
    if (threadIdx.x == 0) {
        unsigned* bar = b.bar;
        __builtin_amdgcn_s_waitcnt(0);
        unsigned nloc = b.st[0], nx = b.st[1];
        if (nloc == 0u) { xcd_barrier_complete(bar, b.x, nloc, nx); b.st[0] = nloc; b.st[1] = nx; }
        const unsigned old = xb_add(&bar[XB_XSUB(b.x)], 1u);
        const unsigned gen = old / nloc;
        if (old + 1u == (gen + 1u) * nloc) {
            __builtin_amdgcn_fence(__ATOMIC_RELEASE, "agent");
            asm volatile("s_waitcnt vmcnt(0)" ::: "memory");
            const unsigned og = xb_add(&bar[XB_TOP], 1u);
            const unsigned tg = og / nx;
            if (og + 1u == (tg + 1u) * nx) xb_add(&bar[XB_TOPGEN], 1u);
            else XB_SPIN(xb_ld(&bar[XB_TOPGEN]) == tg, bar);
            __builtin_amdgcn_fence(__ATOMIC_ACQUIRE, "agent");
            xb_add(&bar[XB_XGEN(b.x)], 1u);
            asm volatile("s_waitcnt vmcnt(0)" ::: "memory");
        } else {
            XB_SPIN(xb_ld(&bar[XB_XGEN(b.x)]) == gen, bar);
            __builtin_amdgcn_fence(__ATOMIC_ACQUIRE, "agent");
            asm volatile("s_waitcnt vmcnt(0)" ::: "memory");
        }
    }
    __syncthreads();
}


__global__ void __launch_bounds__(NT, 2) fwd_mega(Args args) {
    extern __shared__ __attribute__((aligned(16))) unsigned char lds[];
    const int tid = threadIdx.x, lane = tid & 63, wave = __builtin_amdgcn_readfirstlane(tid >> 6);
    const int G = gridDim.x, bid = blockIdx.x;
    const int gw = bid * NW + wave, NGW = G * NW;
    LAS unsigned char* ldsl = (LAS unsigned char*)lds;
    XcdBarrier bar;
    {
        volatile LAS unsigned* st = (volatile LAS unsigned*)(ldsl + LDS_BYTES - 16);
        if (tid < 4) st[tid] = 0u;
        __syncthreads();
        kargp_t kp0 = kargp();
        bar = xcd_barrier_post((unsigned*)((unsigned char*)kp0[21] + OFF_CTL), st);
    }

    {
        PHASE_PTRS
        const float* cvec = KIN(1);
        const float* cctx = KIN(3);
        const float* w_ada = KIN(4);
        const float* w_in = KIN(10);
        const float* w_out = KIN(17);
        const float* w_up = KIN(18);
        const float* w_down = KIN(19);
        float* red = (float*)lds;
        for (int bt = bid; bt < 48 * KSLAB; bt += G) {
            const int cgp = bt % 48, ks = bt / 48, k0 = ks * 128 + wave * 16;
            const float* wp = w_ada + (size_t)k0 * NADA + cgp * 256 + lane * 4;
            f32x4 wv[16];
#pragma unroll
            for (int i = 0; i < 16; ++i) wv[i] = *(const f32x4*)(wp + (size_t)i * NADA);
            f32x4 a0 = {0.f, 0.f, 0.f, 0.f}, a1 = a0, a2 = a0;
#pragma unroll
            for (int i = 0; i < 16; ++i) { const float s0 = silu_(cvec[k0 + i]), s1 = silu_(cvec[D + k0 + i]), s2 = silu_(cctx[k0 + i]);
                a0 += wv[i] * s0; a1 += wv[i] * s1; a2 += wv[i] * s2; }
            *(f32x4*)(red + (wave * 3 + 0) * 256 + lane * 4) = a0; *(f32x4*)(red + (wave * 3 + 1) * 256 + lane * 4) = a1; *(f32x4*)(red + (wave * 3 + 2) * 256 + lane * 4) = a2;
            __syncthreads();
            for (int idx = tid; idx < 768; idx += NT) { const int r = idx >> 8, col = idx & 255; float s = 0.f;
#pragma unroll
                for (int w = 0; w < 8; ++w) s += red[(w * 3 + r) * 256 + col];
                PART[(size_t)(ks * 3 + r) * NADA + cgp * 256 + col] = s; }
            __syncthreads();
        }
        float* scr = (float*)(lds + wave * 16384);
        constexpr int I_IN = (D / 64) * (DIN / 32), I_OUT = (D / 64) * (D / 32), I_UP = (D / 64) * (DFF / 32), I_DN = (DFF / 64) * (D / 32);
        for (int it = gw; it < I_IN + I_OUT + I_UP + I_DN; it += NGW) {
            int r = it;
            if (r < I_IN) { transpose_item(w_in, D, DIN, WinT, scr, r, lane); continue; } r -= I_IN;
            if (r < I_OUT) { transpose_item(w_out, D, D, WoutT, scr, r, lane); continue; } r -= I_OUT;
            if (r < I_UP) { transpose_item(w_up, D, DFF, WupT, scr, r, lane); continue; } r -= I_UP;
            transpose_item(w_down, DFF, D, WdnT, scr, r, lane);
        }
    }
    xcd_barrier(bar);
    {
        PHASE_PTRS
        const float* x = KIN(0);
        const float* ctx = KIN(2);
        const float* b_ada = KIN(5);
        const float* mix_pre_w = KIN(6);
        for (int idx = bid * NT + tid; idx < 3 * NADA; idx += G * NT) { const int r = idx / NADA, n = idx % NADA; float s = b_ada[n];
#pragma unroll
            for (int k = 0; k < KSLAB; ++k) s += PART[(size_t)(k * 3 + r) * NADA + n];
            MOD[idx] = s; }
        float* msh = (float*)lds;
        const int rows_per_blk = M / G;
        const int r0 = bid * rows_per_blk, myb = r0 / SEQ;
        for (int idx = tid; idx < 4 * D; idx += NT) { const int which = idx / (2 * D), n = idx % (2 * D), r = which ? 2 : myb; float s = b_ada[n];
#pragma unroll
            for (int k = 0; k < KSLAB; ++k) s += PART[(size_t)(k * 3 + r) * NADA + n];
            msh[idx] = s; }
        __syncthreads();
        const int nlat = rows_per_blk, nctx = MC / G;
        for (int rr = wave; rr < nlat + nctx; rr += NW) {
            const bool isc = rr >= nlat;
            const int row = isc ? (bid * nctx + rr - nlat) : (r0 + rr);
            const float* xr = isc ? ctx + (size_t)row * D : x + (size_t)row * D;
            const float* ms = msh + (isc ? 2 * D : 0);
            f32x4 v[8]; float ss = 0.f;
#pragma unroll
            for (int j = 0; j < 8; ++j) { v[j] = *(const f32x4*)(xr + lane * 4 + 256 * j); ss += (v[j][0] * v[j][0] + v[j][1] * v[j][1]) + (v[j][2] * v[j][2] + v[j][3] * v[j][3]); }
            const float rstd = rsqrtf(wave_sum(ss) * (1.f / D) + EPS);
            bf16_t* orow = HX + (size_t)(isc ? M + row : row) * D;
#pragma unroll
            for (int j = 0; j < 8; ++j) { const int col = lane * 4 + 256 * j; const f32x4 w = *(const f32x4*)(mix_pre_w + col);
                const f32x4 sh = *(const f32x4*)(ms + col), sc = *(const f32x4*)(ms + D + col);
                f32x4 h = (v[j] * rstd * w) * (sc + 1.f) + sh;
                u32x2 o; o.x = pk2(h[0], h[1]); o.y = pk2(h[2], h[3]); *(u32x2*)(orow + col) = o; }
        }
    }
    xcd_barrier(bar);
    {
        PHASE_PTRS
        pg8::Gemm g{HX, WinT, MT, DIN, D}; pg8::Sched1 S; S.init(G, bid);
        pg8::EpiBf<0> E{Z, DIN};
        pg8::gemm_phase<pg8::EpiBf<0>, pg8::Sched1, true, true>(ldsl, g, S, E);
    }
    xcd_barrier(bar);
    {
        PHASE_PTRS
        const float* x = KIN(0);
        const float* conv_w = KIN(11);
        const float* conv_b = KIN(12);
        const float* conv_ln_w = KIN(13);
        const float* conv_ln_b = KIN(14);
        const int c0 = 2 * tid;
        float w0[31], w1[31];
#pragma unroll
        for (int k = 0; k < 31; ++k) { const f32x2v t = *(const f32x2v*)(conv_w + k * 1024 + c0); w0[k] = t.x; w1[k] = t.y; }
        const f32x2v cb = *(const f32x2v*)(conv_b + c0), lw = *(const f32x2v*)(conv_ln_w + c0), lbv = *(const f32x2v*)(conv_ln_b + c0);
        float* red = (float*)lds;
        for (int it = bid; it < 512; it += G) {
            const int b = it >> 8, t0 = (it & 255) * 16;
            float a0[16], a1[16];
#pragma unroll
            for (int j = 0; j < 16; ++j) { a0[j] = 0.f; a1[j] = 0.f; }
#pragma unroll
            for (int ti = 0; ti < 46; ++ti) {
                const int t = t0 - 15 + ti; const bool ok = (t >= 0) && (t < SEQ); const int tc = t < 0 ? 0 : (t >= SEQ ? SEQ - 1 : t);
                const bf16_t* zr = Z + (size_t)(b * SEQ + tc) * DIN + c0;
                const unsigned av = *(const unsigned*)zr, gv = *(const unsigned*)(zr + 1024);
                const float msk = ok ? 1.f : 0.f;
                const float u0 = bflo(av) * sigm(bflo(gv)) * msk, u1 = bfhi(av) * sigm(bfhi(gv)) * msk;
#pragma unroll
                for (int j = 0; j < 16; ++j) { const int k = ti - j; if (k >= 0 && k <= 30) { a0[j] += w0[k] * u0; a1[j] += w1[k] * u1; } }
            }
            __syncthreads();
#pragma unroll
            for (int j = 0; j < 16; ++j) { a0[j] += cb.x; a1[j] += cb.y; const float s = wave_sum(a0[j] + a1[j]); if (lane == 0) red[wave * 16 + j] = s; }
            __syncthreads();
            float mean[16];
#pragma unroll
            for (int j = 0; j < 16; ++j) { float s = 0.f;
#pragma unroll
                for (int w = 0; w < 8; ++w) s += red[w * 16 + j];
                mean[j] = s * (1.f / 1024.f); }
#pragma unroll
            for (int j = 0; j < 16; ++j) { a0[j] -= mean[j]; a1[j] -= mean[j]; const float q = wave_sum(a0[j] * a0[j] + a1[j] * a1[j]); if (lane == 0) red[128 + wave * 16 + j] = q; }
            __syncthreads();
#pragma unroll
            for (int j = 0; j < 16; ++j) { float q = 0.f;
#pragma unroll
                for (int w = 0; w < 8; ++w) q += red[128 + w * 16 + j];
                const float rstd = rsqrtf(q * (1.f / 1024.f) + EPS);
                const float y0 = silu_(a0[j] * rstd * lw.x + lbv.x), y1 = silu_(a1[j] * rstd * lw.y + lbv.y);
                *(unsigned*)(YCAT + (size_t)(b * SEQ + t0 + j) * D + c0) = pk2(y0, y1); }
        }
    }
    {
        PHASE_PTRS
        const float* x = KIN(0);
        const float* lb_logits = KIN(15);
        bf16_t* KT = (bf16_t*)(lds + 4096);
        bf16_t* VT = (bf16_t*)(lds + 4096 + 18432);
        float* TOT = (float*)(lds + 4096 + 36864);
        const int dk = tid & 127, qt = tid >> 7;
        for (int it = bid; it < 32 * NP; it += G) {
            const int h = it & 7, p = (it >> 3) % NP, db = (it >> 3) / NP, d = db >> 1, b = db & 1;
            const int chain = db * 8 + h;
            const float l0 = lb_logits[d * 1024 + h * 128 + dk], l1 = lb_logits[2048 + d * 1024 + h * 128 + dk];
            const float lbd = 1.f / (1.f + __expf(l1 - l0));
            float g[16], kk[16];
            float run = 0.f;
#pragma unroll
            for (int i = 0; i < 16; ++i) { const float zf = bf1(Z[(size_t)zrow_of(p, b, qt * 16 + i) * DIN + 5120 + d * 1024 + h * 128 + dk]);
                const float f = lbd + (1.f - lbd) * sigm(zf); kk[i] = 1.f - f; run += logf(f); g[i] = run; }
            __syncthreads();
            TOT[qt * 128 + dk] = run;
            {
                const int j = tid >> 3, c8 = tid & 7;
                const bf16_t* vp = Z + (size_t)zrow_of(p, b, j) * DIN + 4096 + h * 128 + c8 * 16;
                const u32x4 v0 = *(const u32x4*)vp, v1 = *(const u32x4*)(vp + 8);
                const unsigned vv[8] = {v0.x, v0.y, v0.z, v0.w, v1.x, v1.y, v1.z, v1.w};
#pragma unroll
                for (int e = 0; e < 8; ++e) { VT[(c8 * 16 + 2 * e) * 72 + j] = (bf16_t)(vv[e] & 0xffffu); VT[(c8 * 16 + 2 * e + 1) * 72 + j] = (bf16_t)(vv[e] >> 16); }
            }
            __syncthreads();
            const float T0 = TOT[dk], T1 = TOT[128 + dk], T2 = TOT[256 + dk], T3 = TOT[384 + dk];
            const float tall = (T0 + T1) + (T2 + T3);
            float before = 0.f; if (qt > 0) before += T0; if (qt > 1) before += T1; if (qt > 2) before += T2;
            const float after = tall - before - run;
#pragma unroll
            for (int i = 0; i < 16; ++i) { const float gi = g[i] - (i ? g[i - 1] : 0.f);
                const float e = d == 0 ? (run - g[i]) + after : (g[i] - gi) + before;
                KT[dk * 72 + qt * 16 + i] = (bf16_t)f2bf(kk[i] * __expf(e)); }
            if (qt == 0) DEC[(size_t)(chain * NP + p) * 128 + dk] = __expf(tall);
            __syncthreads();
            {
                const int fr = lane & 15, fq = lane >> 4;
                bf16x8 a[2];
#pragma unroll
                for (int k2 = 0; k2 < 2; ++k2) a[k2] = *(const bf16x8*)(KT + (16 * wave + fr) * 72 + k2 * 32 + fq * 8);
                bf16_t* kvb = KV + (size_t)(chain * NP + p) * 16384;
#pragma unroll
                for (int tl = 0; tl < 8; ++tl) { f32x4 acc = {0.f, 0.f, 0.f, 0.f};
#pragma unroll
                    for (int k2 = 0; k2 < 2; ++k2) { const bf16x8 bb = *(const bf16x8*)(VT + (tl * 16 + fr) * 72 + k2 * 32 + fq * 8); acc = __builtin_amdgcn_mfma_f32_16x16x32_bf16(a[k2], bb, acc, 0, 0, 0); }
                    u32x2 o; o.x = pk2(acc[0], acc[1]); o.y = pk2(acc[2], acc[3]);
                    *(u32x2*)(kvb + (tl * 16 + fr) * 128 + 16 * wave + fq * 4) = o; }
            }
        }
    }
    xcd_barrier(bar);
    {
        PHASE_PTRS
        const float* x = KIN(0);
        for (int gi = bid * NT + tid; gi < 32 * 4096; gi += G * NT) {
            const int chain = gi >> 12, e4 = (gi & 4095) * 4, d = chain >> 4, dk0 = e4 & 127;
            bf16_t* kvc = KV + (size_t)chain * NP * 16384 + e4; const float* decc = DEC + (size_t)chain * NP * 128 + dk0;
            f32x4 s = {0.f, 0.f, 0.f, 0.f};
#pragma unroll 1
            for (int n0 = 0; n0 < NP; n0 += 17) {
                u32x2 kvv[17]; f32x4 dc[17];
#pragma unroll
                for (int i = 0; i < 17; ++i) { const int n = n0 + i; const int pp = d == 0 ? n : (n < 4 ? 3 - n : 71 - n);
                    kvv[i] = *(const u32x2*)(kvc + (size_t)pp * 16384); dc[i] = *(const f32x4*)(decc + pp * 128); }
#pragma unroll
                for (int i = 0; i < 17; ++i) { const int n = n0 + i; const int pp = d == 0 ? n : (n < 4 ? 3 - n : 71 - n);
                    if (pp >= 4) { u32x2 o; o.x = pk2(s[0], s[1]); o.y = pk2(s[2], s[3]); *(u32x2*)(kvc + (size_t)pp * 16384) = o; }
                    const f32x4 kvf = {bflo(kvv[i].x), bfhi(kvv[i].x), bflo(kvv[i].y), bfhi(kvv[i].y)};
                    s = dc[i] * s + kvf; }
            }
        }
    }
    xcd_barrier(bar);
    {
        PHASE_PTRS
        const float* x = KIN(0);
        const float* lb_logits = KIN(15);
        const float* rec_norm_w = KIN(16);
        bf16_t* QS = (bf16_t*)(lds);
        bf16_t* KS = (bf16_t*)(lds + 17408);
        bf16_t* QE = (bf16_t*)(lds + 2 * 17408);
        bf16_t* SI = (bf16_t*)(lds + 3 * 17408);
        bf16_t* VT = (bf16_t*)(lds + 3 * 17408 + 34816);
        bf16_t* SC = (bf16_t*)(lds + 3 * 17408 + 34816 + 18432);
        float* TOT = (float*)(lds + 3 * 17408 + 34816 + 18432 + 9216);
        float* SSQ = TOT + 512;
        const int dk = tid & 127, qt = tid >> 7, fr = lane & 15, fq = lane >> 4;
        const int tr = (wave & 3) * 16, hh = wave >> 2;
        for (int it = bid; it < 2 * 64 * 8; it += G) {
            const int h = it & 7, m = (it >> 3) & 63, b = it >> 9;
            const int row0 = b * SEQ + m * 64;
            f32x4 oacc[4];
#pragma unroll
            for (int tl = 0; tl < 4; ++tl) oacc[tl] = (f32x4){0.f, 0.f, 0.f, 0.f};
#pragma unroll 1
            for (int d = 0; d < 2; ++d) {
                const int chain = (d * 2 + b) * 8 + h;
                const float l0 = lb_logits[d * 1024 + h * 128 + dk], l1 = lb_logits[2048 + d * 1024 + h * 128 + dk];
                const float lbd = 1.f / (1.f + __expf(l1 - l0));
                float g[16], kk[16], qq[16];
                float run = 0.f;
#pragma unroll
                for (int i = 0; i < 16; ++i) { const bf16_t* zr = Z + (size_t)(row0 + qt * 16 + i) * DIN + h * 128 + dk;
                    const float zf = bf1(zr[5120 + d * 1024]); qq[i] = silu_(bf1(zr[2048]));
                    const float f = lbd + (1.f - lbd) * sigm(zf); kk[i] = 1.f - f; run += logf(f); g[i] = run; }
                __syncthreads();
                TOT[qt * 128 + dk] = run;
                if (d == 0) {
                    const int j = tid >> 3, c8 = tid & 7;
                    const bf16_t* vp = Z + (size_t)(row0 + j) * DIN + 4096 + h * 128 + c8 * 16;
                    const u32x4 v0 = *(const u32x4*)vp, v1 = *(const u32x4*)(vp + 8);
                    const unsigned vv[8] = {v0.x, v0.y, v0.z, v0.w, v1.x, v1.y, v1.z, v1.w};
#pragma unroll
                    for (int e = 0; e < 8; ++e) { VT[(c8 * 16 + 2 * e) * 72 + j] = (bf16_t)(vv[e] & 0xffffu); VT[(c8 * 16 + 2 * e + 1) * 72 + j] = (bf16_t)(vv[e] >> 16); }
                }
                {
                    const bf16_t* sp = KV + (size_t)(chain * NP + 4 + m) * 16384;
#pragma unroll
                    for (int i = 0; i < 4; ++i) { const int idx = tid + i * NT, r = idx >> 4, c = (idx & 15) * 8; *(u32x4*)(SI + r * 136 + c) = *(const u32x4*)(sp + r * 128 + c); }
                }
                __syncthreads();
                const float T0 = TOT[dk], T1 = TOT[128 + dk], T2 = TOT[256 + dk], T3 = TOT[384 + dk];
                float before = 0.f; if (qt > 0) before += T0; if (qt > 1) before += T1; if (qt > 2) before += T2;
                const float tall = (T0 + T1) + (T2 + T3), after = tall - before - run;
                const float bref = d == 0 ? (T0 + T1) : (T2 + T3);
#pragma unroll
                for (int i = 0; i < 16; ++i) { const float gi = g[i] - (i ? g[i - 1] : 0.f);
                    const float bj = d == 0 ? before + g[i] : (run - g[i] + gi) + after;
                    const int j = qt * 16 + i;
                    QS[j * 136 + dk] = (bf16_t)f2bf(qq[i] * __expf(bj - bref));
                    KS[j * 136 + dk] = (bf16_t)f2bf(kk[i] * __expf(bref - bj));
                    QE[j * 136 + dk] = (bf16_t)f2bf(qq[i] * __expf(bj)); }
                __syncthreads();
                {
                    bf16x8 a[4];
#pragma unroll
                    for (int k4 = 0; k4 < 4; ++k4) a[k4] = *(const bf16x8*)(QS + (tr + fr) * 136 + k4 * 32 + fq * 8);
#pragma unroll
                    for (int st = 0; st < 2; ++st) { const int s0 = (hh * 2 + st) * 16; f32x4 acc = {0.f, 0.f, 0.f, 0.f};
#pragma unroll
                        for (int k4 = 0; k4 < 4; ++k4) { const bf16x8 bb = *(const bf16x8*)(KS + (s0 + fr) * 136 + k4 * 32 + fq * 8); acc = __builtin_amdgcn_mfma_f32_16x16x32_bf16(a[k4], bb, acc, 0, 0, 0); }
#pragma unroll
                        for (int jj = 0; jj < 4; ++jj) { const int t = tr + fq * 4 + jj, s = s0 + fr; const bool keep = d == 0 ? (s <= t) : (s >= t);
                            SC[t * 72 + s] = (bf16_t)f2bf(keep ? acc[jj] : 0.f); } }
                }
                __syncthreads();
                {
                    bf16x8 aS[2], aE[4];
#pragma unroll
                    for (int k2 = 0; k2 < 2; ++k2) aS[k2] = *(const bf16x8*)(SC + (tr + fr) * 72 + k2 * 32 + fq * 8);
#pragma unroll
                    for (int k4 = 0; k4 < 4; ++k4) aE[k4] = *(const bf16x8*)(QE + (tr + fr) * 136 + k4 * 32 + fq * 8);
#pragma unroll
                    for (int tl = 0; tl < 4; ++tl) { const int dv0 = (hh * 4 + tl) * 16;
#pragma unroll
                        for (int k2 = 0; k2 < 2; ++k2) { const bf16x8 bb = *(const bf16x8*)(VT + (dv0 + fr) * 72 + k2 * 32 + fq * 8); oacc[tl] = __builtin_amdgcn_mfma_f32_16x16x32_bf16(aS[k2], bb, oacc[tl], 0, 0, 0); }
#pragma unroll
                        for (int k4 = 0; k4 < 4; ++k4) { const bf16x8 bb = *(const bf16x8*)(SI + (dv0 + fr) * 136 + k4 * 32 + fq * 8); oacc[tl] = __builtin_amdgcn_mfma_f32_16x16x32_bf16(aE[k4], bb, oacc[tl], 0, 0, 0); } }
                }
            }
            float ssq[4];
#pragma unroll
            for (int jj = 0; jj < 4; ++jj) { float s = 0.f;
#pragma unroll
                for (int tl = 0; tl < 4; ++tl) s += oacc[tl][jj] * oacc[tl][jj];
                s += __shfl_xor(s, 1); s += __shfl_xor(s, 2); s += __shfl_xor(s, 4); s += __shfl_xor(s, 8); ssq[jj] = s; }
            if (fr == 0) {
#pragma unroll
                for (int jj = 0; jj < 4; ++jj) SSQ[hh * 64 + tr + fq * 4 + jj] = ssq[jj]; }
            __syncthreads();
#pragma unroll
            for (int jj = 0; jj < 4; ++jj) { const int t = tr + fq * 4 + jj; const float rstd = rsqrtf((SSQ[t] + SSQ[64 + t]) * (1.f / 128.f) + EPS);
#pragma unroll
                for (int tl = 0; tl < 4; ++tl) { const int dv = (hh * 4 + tl) * 16 + fr;
                    const float gz = bf1(Z[(size_t)(row0 + t) * DIN + 3072 + h * 128 + dv]);
                    const float o = oacc[tl][jj] * rstd * rec_norm_w[h * 128 + dv] * silu_(gz);
                    YCAT[(size_t)(row0 + t) * D + 1024 + h * 128 + dv] = (bf16_t)f2bf(o); } }
        }
    }
    xcd_barrier(bar);
    {
        PHASE_PTRS
        pg8::Gemm g{YCAT, WoutT, M, D, D}; pg8::StaticOrder S; S.init(M, D, G, bid);
        pg8::EpiF32 E{Y, D};
        pg8::gemm_phase<pg8::EpiF32, pg8::StaticOrder, true, true>(ldsl, g, S, E);
    }
    xcd_barrier(bar);
    {
        PHASE_PTRS
        const float* x = KIN(0);
        const float* mix_post_w = KIN(7);
        const float* mlp_pre_w = KIN(8);
        for (int row = gw; row < M; row += NGW) {
            const int b = row / SEQ; const float* md = MOD + (size_t)b * NADA;
            const float* yr = Y + (size_t)row * D; const float* xr = x + (size_t)row * D; float* orow = out + (size_t)row * D; bf16_t* hrow = HX + (size_t)row * D;
            f32x4 v[8]; float ss = 0.f;
#pragma unroll
            for (int j = 0; j < 8; ++j) { v[j] = *(const f32x4*)(yr + lane * 4 + 256 * j); ss += (v[j][0] * v[j][0] + v[j][1] * v[j][1]) + (v[j][2] * v[j][2] + v[j][3] * v[j][3]); }
            const float rstd = rsqrtf(wave_sum(ss) * (1.f / D) + EPS);
            float ss2 = 0.f;
#pragma unroll
            for (int j = 0; j < 8; ++j) { const int col = lane * 4 + 256 * j;
                const f32x4 xv = *(const f32x4*)(xr + col), w = *(const f32x4*)(mix_post_w + col), g1 = *(const f32x4*)(md + 2 * D + col);
                v[j] = xv + g1 * (v[j] * rstd * w);
                *(f32x4*)(orow + col) = v[j];
                ss2 += (v[j][0] * v[j][0] + v[j][1] * v[j][1]) + (v[j][2] * v[j][2] + v[j][3] * v[j][3]); }
            const float rstd2 = rsqrtf(wave_sum(ss2) * (1.f / D) + EPS);
#pragma unroll
            for (int j = 0; j < 8; ++j) { const int col = lane * 4 + 256 * j;
                const f32x4 w = *(const f32x4*)(mlp_pre_w + col), sh = *(const f32x4*)(md + 3 * D + col), sc = *(const f32x4*)(md + 4 * D + col);
                const f32x4 hv = (v[j] * rstd2 * w) * (sc + 1.f) + sh;
                u32x2 o; o.x = pk2(hv[0], hv[1]); o.y = pk2(hv[2], hv[3]); *(u32x2*)(hrow + col) = o; }
        }
    }
    xcd_barrier(bar);
    {
        PHASE_PTRS
        pg8::Gemm g{HX, WupT, M, DFF, D}; pg8::StaticOrder S; S.init(M, DFF, G, bid);
        pg8::EpiBf<2> E{HID, DFF};
        pg8::gemm_phase<pg8::EpiBf<2>, pg8::StaticOrder, true, true>(ldsl, g, S, E);
    }
    xcd_barrier(bar);
    {
        PHASE_PTRS
        pg8::Gemm g{HID, WdnT, M, D, DFF}; pg8::StaticOrder S; S.init(M, D, G, bid);
        pg8::EpiF32 E{Y, D};
        pg8::gemm_phase<pg8::EpiF32, pg8::StaticOrder, true, true>(ldsl, g, S, E);
    }
    xcd_barrier(bar);
    {
        PHASE_PTRS
        const float* mlp_post_w = KIN(9);
        for (int row = gw; row < M; row += NGW) {
            const int b = row / SEQ; const float* md = MOD + (size_t)b * NADA;
            const float* yr = Y + (size_t)row * D; float* orow = out + (size_t)row * D;
            f32x4 v[8]; float ss = 0.f;
#pragma unroll
            for (int j = 0; j < 8; ++j) { v[j] = *(const f32x4*)(yr + lane * 4 + 256 * j); ss += (v[j][0] * v[j][0] + v[j][1] * v[j][1]) + (v[j][2] * v[j][2] + v[j][3] * v[j][3]); }
            const float rstd = rsqrtf(wave_sum(ss) * (1.f / D) + EPS);
#pragma unroll
            for (int j = 0; j < 8; ++j) { const int col = lane * 4 + 256 * j;
                const f32x4 xv = *(const f32x4*)(orow + col), w = *(const f32x4*)(mlp_post_w + col), g2 = *(const f32x4*)(md + 5 * D + col);
                *(f32x4*)(orow + col) = xv + g2 * (v[j] * rstd * w); }
        }
    }
}

extern "C" void kernel_launch(void* const* d_in, const int* in_sizes, int n_in, void* d_out, int out_size, void* d_ws, size_t ws_size, hipStream_t stream) {
    static int grid = 0;
    if (grid == 0) {
        if (n_in != 20 || out_size != M * D || ws_size < WS_END) { fprintf(stderr, "kernel_launch: unexpected shapes (n_in %d out %d ws %zu)\n", n_in, out_size, ws_size); grid = -1; return; }
        int dev = 0, cus = 0, per_cu = 0;
        hipGetDevice(&dev); hipDeviceGetAttribute(&cus, hipDeviceAttributeMultiprocessorCount, dev);
        hipFuncSetAttribute((const void*)fwd_mega, hipFuncAttributeMaxDynamicSharedMemorySize, LDS_BYTES);
        hipOccupancyMaxActiveBlocksPerMultiprocessor(&per_cu, (const void*)fwd_mega, NT, LDS_BYTES);
        if (per_cu < 1) { fprintf(stderr, "kernel_launch: occupancy query says %d blocks per CU\n", per_cu); per_cu = 1; }
        grid = cus * 1;
        if (grid > 256) grid = 256;
        (void)hipGetLastError();
    }
    if (grid < 0) return;
    Args a{};
    for (int i = 0; i < 20; ++i) a.in[i] = (const float*)d_in[i];
    a.out = (float*)d_out; a.ws = (unsigned char*)d_ws;
    if (hipMemsetAsync((char*)d_ws + OFF_CTL, 0, CTL_BYTES, stream) != hipSuccess) { fprintf(stderr, "kernel_launch: memset failed\n"); return; }
    void* kargs[] = {&a};
    hipError_t e = hipLaunchCooperativeKernel((const void*)fwd_mega, dim3(grid), dim3(NT), kargs, LDS_BYTES, stream);
    if (e != hipSuccess) fprintf(stderr, "cooperative launch failed: %s (grid %d)\n", hipGetErrorString(e), grid);
}
```
